# Optimizing an MI355X kernel written in HIP

```python
import math
import jax, jax.numpy as jnp
from jax import lax
import numpy as np

D_MODEL = 1024
BATCH = 8
SEQ = 4096
DEPTH = 1

CHUNK = 64
Q_BLOCK = 128
A_HEADS = 8
A_HEAD_DIM = 64
A_WIDTH = A_HEADS * A_HEAD_DIM
IDX_HEADS = 8
IDX_DIM = 64
TOPK_MAX = 256
REL_BUCKETS = 32
REL_MAX_DIST = 128
B_WIDTH = 512
CONV_K = 31
PLE_DIM = 256
EPS = 1e-6
IN_SIZES = (A_WIDTH, A_WIDTH, A_WIDTH, A_WIDTH,
            IDX_HEADS * IDX_DIM, IDX_DIM, IDX_HEADS,
            2 * B_WIDTH, B_WIDTH,
            D_MODEL, D_MODEL)
IN_WIDTH = 4 * A_WIDTH + IDX_HEADS * IDX_DIM + IDX_DIM + IDX_HEADS + 3 * B_WIDTH + 2 * D_MODEL

kernel_name = "hybrid_dsa_conformer_gated_block"


def rms_norm(x, g):
    xf = x.astype(jnp.float32)
    y = xf * lax.rsqrt(jnp.mean(xf * xf, axis=-1, keepdims=True) + EPS)
    return (y * g.astype(jnp.float32)).astype(x.dtype)


def layer_norm(x, g, b):
    xf = x.astype(jnp.float32)
    mu = jnp.mean(xf, axis=-1, keepdims=True)
    xc = xf - mu
    var = jnp.mean(xc * xc, axis=-1, keepdims=True)
    y = xc * lax.rsqrt(var + EPS) * g.astype(jnp.float32) + b.astype(jnp.float32)
    return y.astype(x.dtype)


def t5_bucket(rel):
    half = REL_BUCKETS // 2
    max_exact = half // 2
    base = jnp.where(rel > 0, half, 0).astype(jnp.int32)
    n = jnp.abs(rel)
    nf = jnp.maximum(n, 1).astype(jnp.float32)
    large = max_exact + (jnp.log(nf / max_exact) / math.log(REL_MAX_DIST / max_exact)
                         * (half - max_exact)).astype(jnp.int32)
    large = jnp.minimum(large, half - 1)
    return base + jnp.where(n < max_exact, n, large)


def sparse_attention(q, k, v, q_idx, k_idx, w_idx, rel_table):
    bsz, seq = q.shape[0], q.shape[1]
    k_top = min(TOPK_MAX, seq // 4)
    n_blocks = seq // Q_BLOCK
    pos = jnp.arange(seq, dtype=jnp.int32)
    key_chunk = pos // CHUNK
    idx_scale = (IDX_DIM ** -0.5) * (IDX_HEADS ** -0.5)
    attn_scale = A_HEAD_DIM ** -0.5
    gather = jax.vmap(lambda a, i: a[i])

    def to_blocks(a):
        return a.reshape(bsz, n_blocks, Q_BLOCK, *a.shape[2:]).swapaxes(0, 1)

    def block_fn(args):
        qb, qib, wib, qpos = args
        dots = jnp.einsum('bqhd,bkd->bqhk', qib, k_idx).astype(jnp.float32)
        scores = jnp.einsum('bqhk,bqh->bqk', jax.nn.relu(dots),
                            wib.astype(jnp.float32) * idx_scale)
        admissible = key_chunk[None, :] <= (qpos // CHUNK)[:, None]
        scores = jnp.where(admissible[None], scores, -jnp.inf)
        top_val, top_idx = lax.top_k(scores, k_top)
        valid = jnp.isfinite(top_val)
        k_sel = gather(k, top_idx)
        v_sel = gather(v, top_idx)
        logits = jnp.einsum('bqhd,bqkhd->bqhk', qb, k_sel).astype(jnp.float32) * attn_scale
        rel = top_idx - qpos[None, :, None]
        bias = rel_table.astype(jnp.float32)[t5_bucket(rel)]
        logits = logits + jnp.moveaxis(bias, -1, 2)
        logits = jnp.where(valid[:, :, None, :], logits, -jnp.inf)
        probs = jax.nn.softmax(logits, axis=-1).astype(v.dtype)
        return jnp.einsum('bqhk,bqkhd->bqhd', probs, v_sel)

    out = lax.map(block_fn, (to_blocks(q), to_blocks(q_idx), to_blocks(w_idx),
                             pos.reshape(n_blocks, Q_BLOCK)))
    return out.swapaxes(0, 1).reshape(bsz, seq, A_HEADS, A_HEAD_DIM)


def causal_depthwise_conv(u, w, b):
    y = lax.conv_general_dilated(u, w.astype(u.dtype), window_strides=(1,),
                                 padding=[(CONV_K - 1, 0)],
                                 dimension_numbers=('NWC', 'WIO', 'NWC'),
                                 feature_group_count=u.shape[-1])
    return y + b.astype(u.dtype)


def setup_inputs(seed: int = 0) -> dict:
    key = jax.random.key(seed)
    ks = jax.random.split(key, 18)
    f32 = jnp.float32
    nrm = lambda k, shape, scale: jax.random.normal(k, shape, f32) * scale
    return {
        "x": nrm(ks[0], (BATCH, SEQ, D_MODEL), 1.0),
        "p": nrm(ks[1], (DEPTH, BATCH, SEQ, PLE_DIM), 1.0),
        "norm_in_g": 1.0 + nrm(ks[2], (DEPTH, D_MODEL), 0.02),
        "w_in": nrm(ks[3], (DEPTH, D_MODEL, IN_WIDTH), D_MODEL ** -0.5),
        "conv_w": nrm(ks[4], (DEPTH, CONV_K, 1, B_WIDTH), CONV_K ** -0.5),
        "conv_b": nrm(ks[5], (DEPTH, B_WIDTH), 0.02),
        "conv_ln_g": 1.0 + nrm(ks[6], (DEPTH, B_WIDTH), 0.02),
        "conv_ln_b": nrm(ks[7], (DEPTH, B_WIDTH), 0.02),
        "w_branch_a": nrm(ks[8], (DEPTH, A_WIDTH, D_MODEL), A_WIDTH ** -0.5),
        "w_branch_b": nrm(ks[9], (DEPTH, B_WIDTH, D_MODEL), B_WIDTH ** -0.5),
        "w_out": nrm(ks[10], (DEPTH, D_MODEL, D_MODEL), D_MODEL ** -0.5),
        "ple_norm_g": 1.0 + nrm(ks[11], (DEPTH, D_MODEL), 0.02),
        "w_ple_gate": nrm(ks[12], (DEPTH, D_MODEL, D_MODEL), D_MODEL ** -0.5),
        "w_ple_proj": nrm(ks[13], (DEPTH, PLE_DIM, D_MODEL), PLE_DIM ** -0.5),
        "rel_bias": nrm(ks[14], (REL_BUCKETS, A_HEADS), 0.5),
        "final_norm_g": 1.0 + nrm(ks[15], (D_MODEL,), 0.02),
    }


def reference(x, p, norm_in_g, w_in, conv_w, conv_b, conv_ln_g, conv_ln_b,
              w_branch_a, w_branch_b, w_out, ple_norm_g, w_ple_gate, w_ple_proj,
              rel_bias, final_norm_g):
    bsz, seq, _ = x.shape
    offsets = list(np.cumsum(IN_SIZES)[:-1])
    for i in range(DEPTH):
        h = rms_norm(x, norm_in_g[i])
        proj = h @ w_in[i]
        (q, k, v, z_a, q_idx, k_idx, w_idx, glu_in, z_b,
         gate_a, gate_b) = jnp.split(proj, offsets, axis=-1)
        heads = lambda t: t.reshape(bsz, seq, A_HEADS, A_HEAD_DIM)
        attn = sparse_attention(heads(q), heads(k), heads(v),
                                q_idx.reshape(bsz, seq, IDX_HEADS, IDX_DIM),
                                k_idx, w_idx, rel_bias)
        y_a = (attn.reshape(bsz, seq, A_WIDTH) * jax.nn.silu(z_a)) @ w_branch_a[i]
        u = glu_in[..., :B_WIDTH] * jax.nn.sigmoid(glu_in[..., B_WIDTH:])
        c = causal_depthwise_conv(u, conv_w[i], conv_b[i])
        c = jax.nn.silu(layer_norm(c, conv_ln_g[i], conv_ln_b[i]))
        y_b = (c * jax.nn.silu(z_b)) @ w_branch_b[i]
        merged = jax.nn.sigmoid(gate_a) * y_a + jax.nn.sigmoid(gate_b) * y_b
        x = x + merged @ w_out[i]
        e = p[i] @ w_ple_proj[i]
        g = jax.nn.sigmoid(rms_norm(x, ple_norm_g[i]) @ w_ple_gate[i])
        x = x + g * e
    return rms_norm(x, final_norm_g)
```

```cpp
#include <hip/hip_runtime.h>
#include <cstdint>
#include <cstdio>

namespace nv {
constexpr int B = 8, S = 4096, D = 1024, NW = 6216, AW = 512, NH = 8, HD = 64, PLE = 256, CK = 31, TOPK = 256;
constexpr int O_Q = 0, O_K = 512, O_V = 1024, O_ZA = 1536, O_QI = 2048, O_KI = 2560, O_WI = 2624, O_GLU = 2632, O_ZB = 3656, O_GA = 4168, O_GB = 5192;
constexpr float EPS = 1e-6f;
constexpr float IDX_SCALE = 0.125f * 0.35355339059327373f;

__device__ __forceinline__ float sigm(float x) { return 1.f / (1.f + expf(-x)); }
__device__ __forceinline__ float silu(float x) { return x * sigm(x); }
__device__ __forceinline__ float wave_sum(float v) {
#pragma unroll
    for (int o = 32; o > 0; o >>= 1) v += __shfl_xor(v, o);
    return v;
}
__device__ __forceinline__ float wave_max(float v) {
#pragma unroll
    for (int o = 32; o > 0; o >>= 1) v = fmaxf(v, __shfl_xor(v, o));
    return v;
}
__device__ __forceinline__ int wave_sum_i(int v) {
#pragma unroll
    for (int o = 32; o > 0; o >>= 1) v += __shfl_xor(v, o);
    return v;
}
__device__ __forceinline__ int t5_bucket(int rel) {
    const int base = rel > 0 ? 16 : 0;
    const int n = rel < 0 ? -rel : rel;
    int v;
    if (n < 8) v = n;
    else if (n < 12) v = 8;
    else if (n < 16) v = 9;
    else if (n < 23) v = 10;
    else if (n < 32) v = 11;
    else if (n < 46) v = 12;
    else if (n < 64) v = 13;
    else if (n < 91) v = 14;
    else v = 15;
    return base + v;
}

__global__ __launch_bounds__(256) void k_rmsnorm(const float* __restrict__ x, const float* __restrict__ g, float* __restrict__ out) {
    __shared__ float red[4];
    const int row = blockIdx.x, tid = threadIdx.x;
    const float4 v = ((const float4*)(x + (size_t)row * D))[tid];
    float s = v.x * v.x + v.y * v.y + v.z * v.z + v.w * v.w;
    s = wave_sum(s);
    if ((tid & 63) == 0) red[tid >> 6] = s;
    __syncthreads();
    const float tot = red[0] + red[1] + red[2] + red[3];
    const float r = rsqrtf(tot * (1.f / D) + EPS);
    const float4 gg = ((const float4*)g)[tid];
    float4 o; o.x = v.x * r * gg.x; o.y = v.y * r * gg.y; o.z = v.z * r * gg.z; o.w = v.w * r * gg.w;
    ((float4*)(out + (size_t)row * D))[tid] = o;
}

__global__ __launch_bounds__(256) void k_gemm(const float* __restrict__ A, int lda, const float* __restrict__ Bm, int ldb, float* __restrict__ C, int ldc, int N, int K) {
    __shared__ float As[16][68];
    __shared__ float Bs[16][68];
    const int tid = threadIdx.x, tx = tid & 15, ty = tid >> 4;
    const int m0 = blockIdx.y * 64, n0 = blockIdx.x * 64;
    float acc[4][4];
#pragma unroll
    for (int i = 0; i < 4; ++i)
#pragma unroll
        for (int j = 0; j < 4; ++j) acc[i][j] = 0.f;
    for (int k0 = 0; k0 < K; k0 += 16) {
#pragma unroll
        for (int i = 0; i < 4; ++i) { const int e = tid + i * 256, r = e >> 4, c = e & 15; As[c][r] = A[(size_t)(m0 + r) * lda + k0 + c]; }
#pragma unroll
        for (int i = 0; i < 4; ++i) { const int e = tid + i * 256, r = e >> 6, c = e & 63, n = n0 + c; Bs[r][c] = n < N ? Bm[(size_t)(k0 + r) * ldb + n] : 0.f; }
        __syncthreads();
#pragma unroll
        for (int kk = 0; kk < 16; ++kk) {
            float a[4], b[4];
#pragma unroll
            for (int i = 0; i < 4; ++i) { a[i] = As[kk][ty * 4 + i]; b[i] = Bs[kk][tx * 4 + i]; }
#pragma unroll
            for (int i = 0; i < 4; ++i)
#pragma unroll
                for (int j = 0; j < 4; ++j) acc[i][j] = fmaf(a[i], b[j], acc[i][j]);
        }
        __syncthreads();
    }
#pragma unroll
    for (int i = 0; i < 4; ++i)
#pragma unroll
        for (int j = 0; j < 4; ++j) { const int n = n0 + tx * 4 + j; if (n < N) C[(size_t)(m0 + ty * 4 + i) * ldc + n] = acc[i][j]; }
}

__device__ __forceinline__ unsigned mono(float f) { const unsigned u = __float_as_uint(f); return (u & 0x80000000u) ? ~u : (u | 0x80000000u); }

__global__ __launch_bounds__(256) void k_attn(const float* __restrict__ PROJ, const float* __restrict__ rel_bias, float* __restrict__ A1) {
    __shared__ unsigned uk[S];
    __shared__ float qi[512];
    __shared__ float qv[512];
    __shared__ float wv[8];
    __shared__ int sel[256];
    __shared__ float lg[8][256];
    __shared__ int scan[256];
    __shared__ int cnt_s, cnt_g;
    const int q = blockIdx.x, tid = threadIdx.x, lane = tid & 63, wid = tid >> 6;
    const float* row = PROJ + (size_t)q * NW;
    qi[tid] = row[O_QI + tid]; qi[tid + 256] = row[O_QI + 256 + tid];
    qv[tid] = row[O_Q + tid]; qv[tid + 256] = row[O_Q + 256 + tid];
    if (tid < 8) wv[tid] = row[O_WI + tid] * IDX_SCALE;
    __syncthreads();
    const int n = ((q >> 6) + 1) * 64;
    for (int k = tid; k < n; k += 256) {
        const float* kr = PROJ + (size_t)k * NW + O_KI;
        float s = 0.f;
        for (int h = 0; h < 8; ++h) {
            float d = 0.f;
            for (int e = 0; e < 64; ++e) d = fmaf(qi[h * 64 + e], kr[e], d);
            s = fmaf(fmaxf(d, 0.f), wv[h], s);
        }
        uk[k] = mono(s);
    }
    __syncthreads();
    int nsel;
    if (n <= TOPK) {
        nsel = n;
        if (tid < n) sel[tid] = tid;
        __syncthreads();
    } else {
        unsigned T = 0u;
        for (int bit = 31; bit >= 0; --bit) {
            const unsigned tr = T | (1u << bit);
            if (tid == 0) cnt_s = 0;
            __syncthreads();
            int c = 0;
            for (int k = tid; k < n; k += 256) c += (uk[k] >= tr) ? 1 : 0;
            c = wave_sum_i(c);
            if (lane == 0) atomicAdd(&cnt_s, c);
            __syncthreads();
            if (cnt_s >= TOPK) T = tr;
            __syncthreads();
        }
        int cg = 0, ce = 0;
        const int k0 = tid * 16;
        for (int i = 0; i < 16; ++i) { const int k = k0 + i; if (k < n) { const unsigned u = uk[k]; cg += (u > T) ? 1 : 0; ce += (u == T) ? 1 : 0; } }
        if (tid == 0) cnt_g = 0;
        __syncthreads();
        { const int c = wave_sum_i(cg); if (lane == 0) atomicAdd(&cnt_g, c); }
        scan[tid] = ce;
        __syncthreads();
        for (int off = 1; off < 256; off <<= 1) { const int v = scan[tid] + (tid >= off ? scan[tid - off] : 0); __syncthreads(); scan[tid] = v; __syncthreads(); }
        const int erank0 = scan[tid] - ce;
        const int need = TOPK - cnt_g;
        __syncthreads();
        int cs = 0;
        { int er = erank0;
          for (int i = 0; i < 16; ++i) { const int k = k0 + i; if (k < n) { const unsigned u = uk[k]; if (u > T) ++cs; else if (u == T) { if (er < need) ++cs; ++er; } } } }
        scan[tid] = cs;
        __syncthreads();
        for (int off = 1; off < 256; off <<= 1) { const int v = scan[tid] + (tid >= off ? scan[tid - off] : 0); __syncthreads(); scan[tid] = v; __syncthreads(); }
        int pos = scan[tid] - cs;
        { int er = erank0;
          for (int i = 0; i < 16; ++i) { const int k = k0 + i; if (k < n) { const unsigned u = uk[k]; bool s_ = false; if (u > T) s_ = true; else if (u == T) { s_ = er < need; ++er; } if (s_) { if (pos < TOPK) sel[pos] = k; ++pos; } } } }
        nsel = TOPK;
        __syncthreads();
    }
    {
        const int j = tid;
        if (j < nsel) {
            const int kj = sel[j];
            const float* kr = PROJ + (size_t)kj * NW + O_K;
            const int bk = t5_bucket(kj - q);
            for (int h = 0; h < 8; ++h) {
                float d = 0.f;
                for (int e = 0; e < 64; ++e) d = fmaf(qv[h * 64 + e], kr[h * 64 + e], d);
                lg[h][j] = d * 0.125f + rel_bias[bk * 8 + h];
            }
        } else {
            for (int h = 0; h < 8; ++h) lg[h][j] = -INFINITY;
        }
    }
    __syncthreads();
    for (int hh = 0; hh < 2; ++hh) {
        const int h = wid * 2 + hh;
        float v[4]; float m = -INFINITY;
#pragma unroll
        for (int i = 0; i < 4; ++i) { v[i] = lg[h][lane + 64 * i]; m = fmaxf(m, v[i]); }
        m = wave_max(m);
        float s = 0.f;
#pragma unroll
        for (int i = 0; i < 4; ++i) { v[i] = expf(v[i] - m); s += v[i]; }
        s = wave_sum(s);
        const float inv = 1.f / s;
#pragma unroll
        for (int i = 0; i < 4; ++i) lg[h][lane + 64 * i] = v[i] * inv;
    }
    __syncthreads();
    {
        const int o = tid * 2, h = o >> 6;
        float a0 = 0.f, a1 = 0.f;
        for (int j = 0; j < nsel; ++j) {
            const float p = lg[h][j];
            const float2 vv = *(const float2*)(PROJ + (size_t)sel[j] * NW + O_V + o);
            a0 = fmaf(p, vv.x, a0); a1 = fmaf(p, vv.y, a1);
        }
        const float z0 = row[O_ZA + o], z1 = row[O_ZA + o + 1];
        A1[(size_t)q * AW + o] = a0 * silu(z0);
        A1[(size_t)q * AW + o + 1] = a1 * silu(z1);
    }
}

__global__ __launch_bounds__(256) void k_conv(const float* __restrict__ PROJ, const float* __restrict__ cw, const float* __restrict__ cb, const float* __restrict__ lg_, const float* __restrict__ lb_, float* __restrict__ A2) {
    __shared__ float red[4];
    __shared__ float red2[4];
    const int t = blockIdx.x, tid = threadIdx.x;
    float y[2];
#pragma unroll
    for (int cc = 0; cc < 2; ++cc) {
        const int c = tid + cc * 256;
        float acc = cb[c];
        for (int j = 0; j < CK; ++j) {
            const int tt = t - (CK - 1) + j;
            if (tt >= 0) {
                const float* r = PROJ + (size_t)tt * NW + O_GLU;
                const float u = r[c] * sigm(r[512 + c]);
                acc = fmaf(cw[j * 512 + c], u, acc);
            }
        }
        y[cc] = acc;
    }
    float s = wave_sum(y[0] + y[1]);
    if ((tid & 63) == 0) red[tid >> 6] = s;
    __syncthreads();
    const float mu = (red[0] + red[1] + red[2] + red[3]) * (1.f / 512.f);
    const float d0 = y[0] - mu, d1 = y[1] - mu;
    float s2 = wave_sum(d0 * d0 + d1 * d1);
    if ((tid & 63) == 0) red2[tid >> 6] = s2;
    __syncthreads();
    const float var = (red2[0] + red2[1] + red2[2] + red2[3]) * (1.f / 512.f);
    const float rs = rsqrtf(var + EPS);
    const float* row = PROJ + (size_t)t * NW;
#pragma unroll
    for (int cc = 0; cc < 2; ++cc) {
        const int c = tid + cc * 256;
        const float v = (cc == 0 ? d0 : d1) * rs * lg_[c] + lb_[c];
        A2[(size_t)t * 512 + c] = silu(v) * silu(row[O_ZB + c]);
    }
}

__global__ __launch_bounds__(256) void k_merge(const float* __restrict__ PROJ, const float* __restrict__ YA, const float* __restrict__ YB, float* __restrict__ MG) {
    const int t = blockIdx.x;
    const float* row = PROJ + (size_t)t * NW;
    for (int n = threadIdx.x; n < D; n += 256)
        MG[(size_t)t * D + n] = sigm(row[O_GA + n]) * YA[(size_t)t * D + n] + sigm(row[O_GB + n]) * YB[(size_t)t * D + n];
}
__global__ __launch_bounds__(256) void k_add(const float* __restrict__ a, const float* __restrict__ b, float* __restrict__ o) {
    const size_t i = (size_t)blockIdx.x * 256 + threadIdx.x; o[i] = a[i] + b[i];
}
__global__ __launch_bounds__(256) void k_x2(const float* __restrict__ x1, const float* __restrict__ G, const float* __restrict__ E, float* __restrict__ o) {
    const size_t i = (size_t)blockIdx.x * 256 + threadIdx.x; o[i] = x1[i] + sigm(G[i]) * E[i];
}
}

extern "C" void kernel_launch(void* const* d_in, const int* in_sizes, int n_in, void* d_out, int out_size, void* d_ws, size_t ws_size, hipStream_t stream) {
    using namespace nv;
    const float* x = (const float*)d_in[0]; const float* p = (const float*)d_in[1]; const float* norm_in_g = (const float*)d_in[2];
    const float* w_in = (const float*)d_in[3]; const float* conv_w = (const float*)d_in[4]; const float* conv_b = (const float*)d_in[5];
    const float* conv_ln_g = (const float*)d_in[6]; const float* conv_ln_b = (const float*)d_in[7]; const float* w_ba = (const float*)d_in[8];
    const float* w_bb = (const float*)d_in[9]; const float* w_out = (const float*)d_in[10]; const float* ple_g = (const float*)d_in[11];
    const float* w_pg = (const float*)d_in[12]; const float* w_pp = (const float*)d_in[13]; const float* rel_bias = (const float*)d_in[14];
    const float* fin_g = (const float*)d_in[15];
    float* out = (float*)d_out;
    float* ws = (float*)d_ws;
    size_t off = 0;
    auto take = [&](size_t n) { float* r = ws + off; off += n; return r; };
    float* H = take((size_t)S * D); float* PROJ = take((size_t)S * NW); float* A1 = take((size_t)S * AW); float* A2 = take((size_t)S * AW);
    float* YA = take((size_t)S * D); float* YB = take((size_t)S * D); float* MG = take((size_t)S * D); float* T = take((size_t)S * D);
    float* X1 = take((size_t)S * D); float* XN = take((size_t)S * D); float* G = take((size_t)S * D); float* E = take((size_t)S * D); float* X2 = take((size_t)S * D);
    for (int b = 0; b < B; ++b) {
        const float* xb = x + (size_t)b * S * D; const float* pb = p + (size_t)b * S * PLE; float* ob = out + (size_t)b * S * D;
        k_rmsnorm<<<S, 256, 0, stream>>>(xb, norm_in_g, H);
        k_gemm<<<dim3((NW + 63) / 64, S / 64), 256, 0, stream>>>(H, D, w_in, NW, PROJ, NW, NW, D);
        k_attn<<<S, 256, 0, stream>>>(PROJ, rel_bias, A1);
        k_conv<<<S, 256, 0, stream>>>(PROJ, conv_w, conv_b, conv_ln_g, conv_ln_b, A2);
        k_gemm<<<dim3(D / 64, S / 64), 256, 0, stream>>>(A1, AW, w_ba, D, YA, D, D, AW);
        k_gemm<<<dim3(D / 64, S / 64), 256, 0, stream>>>(A2, AW, w_bb, D, YB, D, D, AW);
        k_merge<<<S, 256, 0, stream>>>(PROJ, YA, YB, MG);
        k_gemm<<<dim3(D / 64, S / 64), 256, 0, stream>>>(MG, D, w_out, D, T, D, D, D);
        k_add<<<S * D / 256, 256, 0, stream>>>(xb, T, X1);
        k_rmsnorm<<<S, 256, 0, stream>>>(X1, ple_g, XN);
        k_gemm<<<dim3(D / 64, S / 64), 256, 0, stream>>>(XN, D, w_pg, D, G, D, D, D);
        k_gemm<<<dim3(D / 64, S / 64), 256, 0, stream>>>(pb, PLE, w_pp, D, E, D, D, PLE);
        k_x2<<<S * D / 256, 256, 0, stream>>>(X1, G, E, X2);
        k_rmsnorm<<<S, 256, 0, stream>>>(X2, fin_g, ob);
    }
}
```

```cpp
#include <hip/hip_runtime.h>
#include <cstdio>
#include <cstdint>
#define MK_N_LAUNCHES 1
namespace pg8 {
#define PG8_LAS __attribute__((address_space(3)))
typedef unsigned short bf16_t;
typedef short bf16x8 __attribute__((ext_vector_type(8)));
typedef float f32x4 __attribute__((ext_vector_type(4)));
typedef unsigned u32x4 __attribute__((ext_vector_type(4)));
constexpr int BM = 256, BK = 64, HALF = 128, HTB = HALF * BK * 2  , STAGE_BYTES = 8 * HTB, NXCD = 8, WGM = 8;

__host__ __device__ __forceinline__ int lds_byte(int r, int c) { const int st = (r >> 4) * 2 + (c >> 5), rr = r & 15, cc = c & 31, ob = rr * 64 + cc * 2; return st * 1024 + (ob ^ (((ob >> 9) & 1) << 5)); }
__host__ __device__ __forceinline__ void stage_rc(int b, int& R, int& C) { const int st = b / 1024, sb = b % 1024, swz = sb ^ (((sb >> 9) & 1) << 5); R = (st >> 1) * 16 + swz / 64; C = (st & 1) * 32 + (swz % 64) / 2; }
__host__ __device__ __forceinline__ int perm32(int rho) { const int n = rho >> 4, i = rho & 15; return 8 * (i >> 2) + 4 * n + (i & 3); }

struct Unit { int pm, pn; };
struct Gemm { const bf16_t* A; const bf16_t* Bt; int M, N, K; };

struct StaticOrder {
    int nM, nN, nwg, G, c;
    __host__ __device__ void init(int M, int N, int G_, int c_) { nM = M / BM; nN = N / BM; nwg = nM * nN; G = G_; c = c_; }
    __host__ __device__ bool next(int i, Unit& u) const {
        const long L = (long)i * G + c; if (L >= nwg) return false;
        int wgid = (int)L; { const int q = nwg / NXCD, r = nwg % NXCD, xcd = wgid % NXCD, off = wgid / NXCD; wgid = (xcd < r ? xcd * (q + 1) : r * (q + 1) + (xcd - r) * q) + off; }
        const int nig = WGM * nN, gid = wgid / nig, fm = gid * WGM, gsz = (nM - fm) < WGM ? (nM - fm) : WGM;
        u.pm = fm + ((wgid % nig) % gsz); u.pn = (wgid % nig) / gsz; return true;
    }
    __device__ __forceinline__ void a_ready(const Unit&) const {}
    __device__ __forceinline__ void done(const Unit&) const {}
};

__device__ __forceinline__ unsigned cvt_pk_bf16(float lo, float hi) { unsigned r; asm volatile("v_cvt_pk_bf16_f32 %0, %1, %2" : "=v"(r) : "v"(lo), "v"(hi)); return r; }
typedef float f32x2 __attribute__((ext_vector_type(2)));
template <class Epi, class Sched, bool ALIGN_EPI = false, bool SP2 = false>
__device__ __forceinline__ void gemm_phase(PG8_LAS unsigned char* lds, const Gemm g, const Sched& S, const Epi& E) {
    const int tid = threadIdx.x, wid = __builtin_amdgcn_readfirstlane(tid >> 6), lane = tid & 63, wr = wid >> 2, wc = wid & 3, fr = lane & 15, fq = lane >> 4;
    const int K = g.K, nt = K / BK;
    unsigned voffA[2], voffB[2];
#pragma unroll
    for (int i = 0; i < 2; ++i) { int R, C; stage_rc(tid * 16 + i * 8192, R, C); const int Rb = Epi::PERM ? ((R & ~31) + perm32(R & 31)) : R;
        voffA[i] = (unsigned)(R * K + C) * 2u; voffB[i] = (unsigned)(Rb * K + C) * 2u; }
    const size_t kstep = (size_t)(BK * 2);
    const size_t hstep = (size_t)HALF * K * 2;
    const size_t tstep = 2 * hstep;
    const unsigned ldsw = (unsigned)wid * 1024u;
    const int aoff = lds_byte(wr * 64 + fr, fq * 8), boff = lds_byte(wc * 32 + fr, fq * 8);
#define PG8_SA(b, h) (((b) * 2 + (h)) * HTB)
#define PG8_SB(b, h) ((4 + (b) * 2 + (h)) * HTB)
#define PG8_STAGE(bufoff, gbase, voff) do { _Pragma("unroll") for (int _i = 0; _i < 2; ++_i) \
        __builtin_amdgcn_global_load_lds((const unsigned*)((const char*)(gbase) + (voff)[_i]), (PG8_LAS unsigned*)(lds + (bufoff) + ldsw + _i * 8192), 16, 0, 0); } while (0)
#define PG8_LDA(dst, b, h) do { _Pragma("unroll") for (int m = 0; m < 4; ++m) _Pragma("unroll") for (int k = 0; k < 2; ++k) dst[m][k] = *(const PG8_LAS bf16x8*)(lds + PG8_SA(b, h) + aoff + m * 2048 + k * 1024); } while (0)
#define PG8_LDB(dst, b, h) do { _Pragma("unroll") for (int n = 0; n < 2; ++n) _Pragma("unroll") for (int k = 0; k < 2; ++k) dst[n][k] = *(const PG8_LAS bf16x8*)(lds + PG8_SB(b, h) + boff + n * 2048 + k * 1024); } while (0)
#define PG8_MMA(ai, bj, At, Bt) do { __builtin_amdgcn_s_setprio(1); _Pragma("unroll") for (int m = 0; m < 4; ++m) _Pragma("unroll") for (int n = 0; n < 2; ++n) _Pragma("unroll") for (int k = 0; k < 2; ++k) \
        acc[ai][bj][m][n] = __builtin_amdgcn_mfma_f32_16x16x32_bf16(Bt[n][k], At[m][k], acc[ai][bj][m][n], 0, 0, 0); __builtin_amdgcn_s_setprio(0); } while (0)
#define PG8_WAIT_V(n) asm volatile("s_waitcnt vmcnt(" #n ")" ::: "memory")
#define PG8_WAIT_L(n) asm volatile("s_waitcnt lgkmcnt(" #n ")" ::: "memory")
#define PG8_BAR __builtin_amdgcn_s_barrier()
#define PG8_SCHED __builtin_amdgcn_sched_barrier(0)
    Unit cur, nxt; int ui = 0;
    if (!S.next(0, cur)) return;
    f32x4 acc[2][2][4][2];
#pragma unroll
    for (int a = 0; a < 2; ++a)
#pragma unroll
        for (int b = 0; b < 2; ++b)
#pragma unroll
            for (int m = 0; m < 4; ++m)
#pragma unroll
                for (int n = 0; n < 2; ++n) acc[a][b][m][n] = (f32x4){0.f, 0.f, 0.f, 0.f};
    bf16x8 At[4][2], B0[2][2], B1[2][2];
    const char* cA = (const char*)g.A + (size_t)cur.pm * tstep; const char* cB = (const char*)g.Bt + (size_t)cur.pn * tstep;
    S.a_ready(cur);
    if constexpr (SP2) {
        PG8_STAGE(PG8_SB(0, 0), cB, voffB); PG8_STAGE(PG8_SB(0, 1), cB + hstep, voffB); PG8_STAGE(PG8_SA(0, 0), cA, voffA); PG8_STAGE(PG8_SA(0, 1), cA + hstep, voffA);
        if (wr == 1) PG8_BAR;
        PG8_WAIT_V(2); PG8_BAR;
        PG8_STAGE(PG8_SB(1, 0), cB + kstep, voffB); PG8_STAGE(PG8_SA(1, 0), cA + kstep, voffA); PG8_STAGE(PG8_SB(1, 1), cB + hstep + kstep, voffB);
        PG8_WAIT_V(6); PG8_BAR;
    } else {
        PG8_STAGE(PG8_SB(0, 0), cB, voffB); PG8_STAGE(PG8_SA(0, 0), cA, voffA); PG8_STAGE(PG8_SB(0, 1), cB + hstep, voffB); PG8_STAGE(PG8_SA(0, 1), cA + hstep, voffA);
        if (wr == 1) PG8_BAR;
        PG8_WAIT_V(4); PG8_BAR;
        PG8_STAGE(PG8_SB(1, 0), cB + kstep, voffB); PG8_STAGE(PG8_SA(1, 0), cA + kstep, voffA); PG8_STAGE(PG8_SB(1, 1), cB + hstep + kstep, voffB);
        PG8_WAIT_V(6); PG8_BAR;
    }
    for (;;) {
        const bool has_next = S.next(ui + 1, nxt);
        const char* nA = has_next ? (const char*)g.A + (size_t)nxt.pm * tstep : cA; const char* nB = has_next ? (const char*)g.Bt + (size_t)nxt.pn * tstep : cB;
        for (int t = 0; t < nt; t += 2) {
            const bool last = (t == nt - 2);
            const char* a1 = cA + (size_t)(t + 1) * kstep;
            const char* a2 = last ? nA : cA + (size_t)(t + 2) * kstep; const char* b2 = last ? nB : cB + (size_t)(t + 2) * kstep;
            const char* a3 = a2 + kstep; const char* b3 = b2 + kstep;
            if (last && has_next) S.a_ready(nxt);
            if constexpr (SP2) {
            PG8_LDB(B0, 0, 0); PG8_LDB(B1, 0, 1); PG8_SCHED; PG8_LDA(At, 0, 0); PG8_STAGE(PG8_SA(1, 1), a1 + hstep, voffA);
            PG8_WAIT_V(8); PG8_WAIT_L(0); PG8_BAR; PG8_MMA(0, 0, At, B0); PG8_MMA(0, 1, At, B1); PG8_BAR; PG8_SCHED;
            PG8_LDA(At, 0, 1); PG8_STAGE(PG8_SB(0, 0), b2, voffB); PG8_STAGE(PG8_SB(0, 1), b2 + hstep, voffB); PG8_STAGE(PG8_SA(0, 0), a2, voffA);
            PG8_WAIT_V(8); PG8_WAIT_L(0); PG8_BAR; PG8_MMA(1, 0, At, B0); PG8_MMA(1, 1, At, B1); PG8_BAR; PG8_SCHED;
            PG8_LDB(B0, 1, 0); PG8_LDB(B1, 1, 1); PG8_SCHED; PG8_LDA(At, 1, 0); PG8_STAGE(PG8_SA(0, 1), a2 + hstep, voffA);
            PG8_WAIT_V(8); PG8_WAIT_L(0); PG8_BAR; PG8_MMA(0, 0, At, B0); PG8_MMA(0, 1, At, B1); PG8_BAR; PG8_SCHED;
            PG8_LDA(At, 1, 1); PG8_STAGE(PG8_SB(1, 0), b3, voffB); PG8_STAGE(PG8_SB(1, 1), b3 + hstep, voffB); PG8_STAGE(PG8_SA(1, 0), a3, voffA);
            PG8_WAIT_V(8); PG8_WAIT_L(0); PG8_BAR; PG8_MMA(1, 0, At, B0); PG8_MMA(1, 1, At, B1); PG8_BAR; PG8_SCHED;
            } else {
            PG8_LDB(B0, 0, 0); PG8_SCHED; PG8_LDA(At, 0, 0); PG8_STAGE(PG8_SA(1, 1), a1 + hstep, voffA);
            PG8_WAIT_L(8); PG8_BAR; PG8_WAIT_L(0); PG8_MMA(0, 0, At, B0); PG8_BAR; PG8_SCHED;
            PG8_LDB(B1, 0, 1); PG8_STAGE(PG8_SB(0, 0), b2, voffB);
            PG8_BAR; PG8_WAIT_L(0); PG8_MMA(0, 1, At, B1); PG8_BAR;
            PG8_LDA(At, 0, 1); PG8_STAGE(PG8_SA(0, 0), a2, voffA);
            PG8_BAR; PG8_WAIT_L(0); PG8_MMA(1, 0, At, B0); PG8_BAR; PG8_SCHED;
            PG8_STAGE(PG8_SB(0, 1), b2 + hstep, voffB);
            PG8_WAIT_V(6); PG8_BAR; PG8_MMA(1, 1, At, B1); PG8_BAR;
            PG8_LDB(B0, 1, 0); PG8_SCHED; PG8_LDA(At, 1, 0); PG8_STAGE(PG8_SA(0, 1), a2 + hstep, voffA);
            PG8_WAIT_L(8); PG8_BAR; PG8_WAIT_L(0); PG8_MMA(0, 0, At, B0); PG8_BAR; PG8_SCHED;
            PG8_LDB(B1, 1, 1); PG8_STAGE(PG8_SB(1, 0), b3, voffB);
            PG8_BAR; PG8_WAIT_L(0); PG8_MMA(0, 1, At, B1); PG8_BAR;
            PG8_LDA(At, 1, 1); PG8_STAGE(PG8_SA(1, 0), a3, voffA);
            PG8_BAR; PG8_WAIT_L(0); PG8_MMA(1, 0, At, B0); PG8_BAR; PG8_SCHED;
            PG8_STAGE(PG8_SB(1, 1), b3 + hstep, voffB);
            PG8_WAIT_V(6); PG8_BAR; PG8_MMA(1, 1, At, B1); PG8_BAR;
            }
        }
        if constexpr (ALIGN_EPI) { if (wr == 0) PG8_BAR; }
        if constexpr (!Epi::AFTER_DRAIN) { E(acc, cur, wr, wc, fr, fq); S.done(cur); }
        if (!has_next) break;
        if (!E.keep(cur)) {
#pragma unroll
        for (int a = 0; a < 2; ++a)
#pragma unroll
            for (int b = 0; b < 2; ++b)
#pragma unroll
                for (int m = 0; m < 4; ++m)
#pragma unroll
                    for (int n = 0; n < 2; ++n) acc[a][b][m][n] = (f32x4){0.f, 0.f, 0.f, 0.f};
        }
        cur = nxt; cA = nA; cB = nB; ++ui;
        if constexpr (ALIGN_EPI) { if (wr == 1) PG8_BAR; }
    }
    PG8_WAIT_V(0);
    if constexpr (!ALIGN_EPI) { if (wr == 0) PG8_BAR; }
    PG8_BAR;
    if constexpr (Epi::AFTER_DRAIN) { E.fused(acc, cur, wr, wc, fr, fq, lds, wid, lane); S.done(cur); }
#undef PG8_SA
#undef PG8_SB
#undef PG8_STAGE
#undef PG8_LDA
#undef PG8_LDB
#undef PG8_MMA
#undef PG8_WAIT_V
#undef PG8_WAIT_L
#undef PG8_BAR
#undef PG8_SCHED
}
}

#ifndef PG8_SP2
#define PG8_SP2 true
#endif
#ifndef PG8_ALIGN
#define PG8_ALIGN true
#endif
namespace pg8 {
typedef unsigned u32x2 __attribute__((ext_vector_type(2)));
__device__ __forceinline__ unsigned cvtpk(float lo, float hi) { typedef float f2_ __attribute__((ext_vector_type(2))); typedef __bf16 b2_ __attribute__((ext_vector_type(2))); f2_ v = {lo, hi}; b2_ b = __builtin_convertvector(v, b2_); return __builtin_bit_cast(unsigned, b); }
__device__ __forceinline__ float bflo(unsigned u) { return __uint_as_float(u << 16); }
__device__ __forceinline__ float bfhi(unsigned u) { return __uint_as_float(u & 0xffff0000u); }
__device__ __forceinline__ float sigm_f(float x) { return __builtin_amdgcn_rcpf(1.0f + __builtin_amdgcn_exp2f(-1.4426950408889634f * x)); }
constexpr float Q_SCALE = 0.125f * 1.4426950408889634f;
constexpr float IDX_SCALE = 0.125f * 0.35355339059327373f;

__device__ __forceinline__ void prefetch_tile_bf16(const bf16_t* base, int ldc, int row0, int col0, PG8_LAS unsigned char* lds, int tid) {
    PG8_LAS unsigned* scrap = (PG8_LAS unsigned*)(lds + 135168 + (tid >> 6) * 256);
#pragma unroll
    for (int j = 0; j < 2; ++j) { const int li = tid + 512 * j; const bf16_t* p = base + (size_t)(row0 + (li >> 2)) * ldc + col0 + (li & 3) * 64;
        __builtin_amdgcn_global_load_lds((const unsigned*)p, scrap, 4, 0, 0); }
}
struct EpiP1 {
    static constexpr bool PERM = true, AFTER_DRAIN = false;
    __device__ __forceinline__ bool keep(const Unit&) const { return false; }
    __device__ __forceinline__ void prefetch(const Unit&, PG8_LAS unsigned char*, int) const {}
    const float* rs0; bf16_t *Q, *Kb, *V, *ZA, *QI, *U, *ZB, *GA, *GB, *KI; float* WI;
    __device__ __forceinline__ void operator()(const f32x4 (&acc)[2][2][4][2], const Unit& u, int wr, int wc, int fr, int fq) const {
        const int pn = u.pn; const int row0 = u.pm * BM + wr * 64 + fr;
        int type = 0; bf16_t* base = Q; int ld = 512, colt = 0; float sc = 1.f;
        if (pn < 10) { const int sec = pn >> 1; base = sec == 0 ? Q : sec == 1 ? Kb : sec == 2 ? V : sec == 3 ? ZA : QI; colt = (pn & 1) * 256; type = (sec == 3) ? 1 : 0; if (sec == 0) sc = Q_SCALE; }
        else if (pn < 14) { type = 3; base = U; colt = (pn - 10) * 128; }
        else if (pn < 16) { type = 1; base = ZB; colt = (pn - 14) * 256; }
        else if (pn < 20) { type = 2; base = GA; ld = 1024; colt = (pn - 16) * 256; }
        else if (pn < 24) { type = 2; base = GB; ld = 1024; colt = (pn - 20) * 256; }
        else type = 4;
        const int col0 = colt + wc * 32 + 8 * fq;
        float rsv[2][4];
#pragma unroll
        for (int ai = 0; ai < 2; ++ai)
#pragma unroll
            for (int m = 0; m < 4; ++m) rsv[ai][m] = rs0[row0 + ai * HALF + m * 16];
        asm volatile("" ::: "memory");
#pragma unroll
        for (int ai = 0; ai < 2; ++ai)
#pragma unroll
            for (int m = 0; m < 4; ++m) {
                const int row = row0 + ai * HALF + m * 16;
                const float r = rsv[ai][m] * sc;
                if (type <= 2) {
                    bf16_t* rowp = base + (size_t)row * ld + col0;
#pragma unroll
                    for (int bj = 0; bj < 2; ++bj) {
                        f32x4 v0 = acc[ai][bj][m][0] * r, v1 = acc[ai][bj][m][1] * r;
                        if (type == 1) {
#pragma unroll
                            for (int e = 0; e < 4; ++e) { v0[e] = v0[e] * sigm_f(v0[e]); v1[e] = v1[e] * sigm_f(v1[e]); }
                        } else if (type == 2) {
#pragma unroll
                            for (int e = 0; e < 4; ++e) { v0[e] = sigm_f(v0[e]); v1[e] = sigm_f(v1[e]); }
                        }
                        u32x4 w; w.x = cvtpk(v0[0], v0[1]); w.y = cvtpk(v0[2], v0[3]); w.z = cvtpk(v1[0], v1[1]); w.w = cvtpk(v1[2], v1[3]);
                        if (type == 2) __builtin_nontemporal_store(w, (u32x4*)(rowp + bj * HALF));
                        else *(u32x4*)(rowp + bj * HALF) = w;
                    }
                } else if (type == 3) {
                    f32x4 a0 = acc[ai][0][m][0] * r, a1 = acc[ai][0][m][1] * r, b0 = acc[ai][1][m][0] * r, b1 = acc[ai][1][m][1] * r;
#pragma unroll
                    for (int e = 0; e < 4; ++e) { a0[e] = a0[e] * sigm_f(b0[e]); a1[e] = a1[e] * sigm_f(b1[e]); }
                    u32x4 w; w.x = cvtpk(a0[0], a0[1]); w.y = cvtpk(a0[2], a0[3]); w.z = cvtpk(a1[0], a1[1]); w.w = cvtpk(a1[2], a1[3]);
                    *(u32x4*)(base + (size_t)row * 512 + col0) = w;
                } else {
                    if (wc < 2) {
                        const f32x4 v0 = acc[ai][0][m][0] * r, v1 = acc[ai][0][m][1] * r;
                        u32x4 w; w.x = cvtpk(v0[0], v0[1]); w.y = cvtpk(v0[2], v0[3]); w.z = cvtpk(v1[0], v1[1]); w.w = cvtpk(v1[2], v1[3]);
                        const int c0 = wc * 32 + 8 * fq;
                        *(u32x4*)(KI + (size_t)(row >> 5) * 2048 + (((c0 >> 4) * 2 + ((c0 >> 3) & 1)) * 32 + (row & 31)) * 8) = w;
                    } else if (wc == 2 && fq == 0) {
                        const float rr = r * IDX_SCALE;
                        *(f32x4*)(WI + (size_t)row * 8) = acc[ai][0][m][0] * rr;
                        *(f32x4*)(WI + (size_t)row * 8 + 4) = acc[ai][0][m][1] * rr;
                    }
                }
            }
    }
};

template <bool ADD> struct EpiGate {
    static constexpr bool PERM = true, AFTER_DRAIN = false;
    __device__ __forceinline__ bool keep(const Unit&) const { return false; }
    __device__ __forceinline__ void prefetch(const Unit&, PG8_LAS unsigned char*, int) const {}
    const bf16_t* G; bf16_t* O; int ldc;
    __device__ __forceinline__ void operator()(const f32x4 (&acc)[2][2][4][2], const Unit& u, int wr, int wc, int fr, int fq) const {
        const int row0 = u.pm * BM + wr * 64 + fr, col0 = u.pn * BM + wc * 32 + 8 * fq;
#pragma unroll
        for (int ai = 0; ai < 2; ++ai) {
            u32x4 gv[4][2], ov[4][2];
#pragma unroll
            for (int m = 0; m < 4; ++m)
#pragma unroll
                for (int bj = 0; bj < 2; ++bj) { const size_t off = (size_t)(row0 + ai * HALF + m * 16) * ldc + col0 + bj * HALF; gv[m][bj] = *(const u32x4*)(G + off); if (ADD) ov[m][bj] = *(const u32x4*)(O + off); }
            asm volatile("" ::: "memory");
#pragma unroll
            for (int m = 0; m < 4; ++m)
#pragma unroll
                for (int bj = 0; bj < 2; ++bj) {
                    const size_t off = (size_t)(row0 + ai * HALF + m * 16) * ldc + col0 + bj * HALF; const u32x4 g = gv[m][bj];
                    f32x4 v0 = acc[ai][bj][m][0], v1 = acc[ai][bj][m][1];
                    v0[0] *= bflo(g.x); v0[1] *= bfhi(g.x); v0[2] *= bflo(g.y); v0[3] *= bfhi(g.y); v1[0] *= bflo(g.z); v1[1] *= bfhi(g.z); v1[2] *= bflo(g.w); v1[3] *= bfhi(g.w);
                    if (ADD) { const u32x4 o = ov[m][bj];
                        v0[0] += bflo(o.x); v0[1] += bfhi(o.x); v0[2] += bflo(o.y); v0[3] += bfhi(o.y); v1[0] += bflo(o.z); v1[1] += bfhi(o.z); v1[2] += bflo(o.w); v1[3] += bfhi(o.w); }
                    u32x4 w; w.x = cvtpk(v0[0], v0[1]); w.y = cvtpk(v0[2], v0[3]); w.z = cvtpk(v1[0], v1[1]); w.w = cvtpk(v1[2], v1[3]);
                    *(u32x4*)(O + off) = w;
                }
            asm volatile("" ::: "memory");
        }
    }
};

struct PairOrder {
    StaticOrder so; int dpm, dpn;
    __device__ bool next(int i, Unit& u) const { Unit b; if (!so.next(i >> 1, b)) return false; u.pm = b.pm + ((i & 1) ? dpm : 0); u.pn = b.pn + ((i & 1) ? dpn : 0); return true; }
    __device__ __forceinline__ void a_ready(const Unit&) const {}
    __device__ __forceinline__ void done(const Unit&) const {}
};
struct EpiBranch {
    static constexpr bool PERM = true, AFTER_DRAIN = false;
    const bf16_t* GA; const bf16_t* GB; bf16_t* O; int ldc, dpm, dpn;
    __device__ __forceinline__ bool keep(const Unit& u) const { return u.pm < dpm; }
    __device__ __forceinline__ void prefetch(const Unit& u, PG8_LAS unsigned char* lds, int tid) const { if (u.pm < dpm) { prefetch_tile_bf16(GA, ldc, u.pm * BM, u.pn * BM, lds, tid); prefetch_tile_bf16(GB, ldc, u.pm * BM, u.pn * BM, lds, tid); } }
    __device__ __forceinline__ void operator()(f32x4 (&acc)[2][2][4][2], const Unit& u, int wr, int wc, int fr, int fq) const {
        const bool second = u.pm >= dpm; const int pm = second ? u.pm - dpm : u.pm, pn = second ? u.pn - dpn : u.pn;
        const int row0 = pm * BM + wr * 64 + fr, col0 = pn * BM + wc * 32 + 8 * fq;
#pragma unroll
        for (int ai = 0; ai < 2; ++ai) {
            u32x4 gb[4][2], ga[4][2];
#pragma unroll
            for (int m = 0; m < 4; ++m)
#pragma unroll
                for (int bj = 0; bj < 2; ++bj) { const size_t off = (size_t)(row0 + ai * HALF + m * 16) * ldc + col0 + bj * HALF; gb[m][bj] = second ? __builtin_nontemporal_load((const u32x4*)(GB + off)) : *(const u32x4*)(GB + off); if (!second) ga[m][bj] = __builtin_nontemporal_load((const u32x4*)(GA + off)); }
            asm volatile("" ::: "memory");
#pragma unroll
            for (int m = 0; m < 4; ++m)
#pragma unroll
                for (int bj = 0; bj < 2; ++bj) {
                    const u32x4 b = gb[m][bj];
                    if (!second) {
                        const u32x4 a = ga[m][bj];
                        acc[ai][bj][m][0][0] *= bflo(a.x) * __builtin_amdgcn_rcpf(bflo(b.x)); acc[ai][bj][m][0][1] *= bfhi(a.x) * __builtin_amdgcn_rcpf(bfhi(b.x));
                        acc[ai][bj][m][0][2] *= bflo(a.y) * __builtin_amdgcn_rcpf(bflo(b.y)); acc[ai][bj][m][0][3] *= bfhi(a.y) * __builtin_amdgcn_rcpf(bfhi(b.y));
                        acc[ai][bj][m][1][0] *= bflo(a.z) * __builtin_amdgcn_rcpf(bflo(b.z)); acc[ai][bj][m][1][1] *= bfhi(a.z) * __builtin_amdgcn_rcpf(bfhi(b.z));
                        acc[ai][bj][m][1][2] *= bflo(a.w) * __builtin_amdgcn_rcpf(bflo(b.w)); acc[ai][bj][m][1][3] *= bfhi(a.w) * __builtin_amdgcn_rcpf(bfhi(b.w));
                    } else {
                        const f32x4 v0 = acc[ai][bj][m][0], v1 = acc[ai][bj][m][1];
                        u32x4 w; w.x = cvtpk(v0[0] * bflo(b.x), v0[1] * bfhi(b.x)); w.y = cvtpk(v0[2] * bflo(b.y), v0[3] * bfhi(b.y)); w.z = cvtpk(v1[0] * bflo(b.z), v1[1] * bfhi(b.z)); w.w = cvtpk(v1[2] * bflo(b.w), v1[3] * bfhi(b.w));
                        *(u32x4*)(O + (size_t)(row0 + ai * HALF + m * 16) * ldc + col0 + bj * HALF) = w;
                    }
                }
            asm volatile("" ::: "memory");
        }
    }
};

struct EpiPlain {
    static constexpr bool PERM = true, AFTER_DRAIN = false;
    __device__ __forceinline__ bool keep(const Unit&) const { return false; }
    __device__ __forceinline__ void prefetch(const Unit&, PG8_LAS unsigned char*, int) const {}
    bf16_t* O; int ldc;
    __device__ __forceinline__ void operator()(const f32x4 (&acc)[2][2][4][2], const Unit& u, int wr, int wc, int fr, int fq) const {
        const int row0 = u.pm * BM + wr * 64 + fr, col0 = u.pn * BM + wc * 32 + 8 * fq;
#pragma unroll
        for (int ai = 0; ai < 2; ++ai)
#pragma unroll
            for (int m = 0; m < 4; ++m) {
                bf16_t* rowp = O + (size_t)(row0 + ai * HALF + m * 16) * ldc + col0;
#pragma unroll
                for (int bj = 0; bj < 2; ++bj) {
                    const f32x4 v0 = acc[ai][bj][m][0], v1 = acc[ai][bj][m][1];
                    u32x4 w; w.x = cvtpk(v0[0], v0[1]); w.y = cvtpk(v0[2], v0[3]); w.z = cvtpk(v1[0], v1[1]); w.w = cvtpk(v1[2], v1[3]);
                    *(u32x4*)(rowp + bj * HALF) = w;
                }
            }
    }
};

struct EpiX1 {
    static constexpr bool PERM = true, AFTER_DRAIN = false;
    __device__ __forceinline__ bool keep(const Unit&) const { return false; }
    __device__ __forceinline__ void prefetch(const Unit& u, PG8_LAS unsigned char* lds, int tid) const { prefetch_tile_bf16(xin, ldc, u.pm * BM, u.pn * BM, lds, tid); }
    const bf16_t* xin; bf16_t* x1b; float* rss; int ldc;
    __device__ __forceinline__ void operator()(const f32x4 (&acc)[2][2][4][2], const Unit& u, int wr, int wc, int fr, int fq) const {
        const int row0 = u.pm * BM + wr * 64 + fr, col0 = u.pn * BM + wc * 32 + 8 * fq;
#pragma unroll
        for (int ai = 0; ai < 2; ++ai) {
            u32x4 xv[4][2];
#pragma unroll
            for (int m = 0; m < 4; ++m)
#pragma unroll
                for (int bj = 0; bj < 2; ++bj) xv[m][bj] = *(const u32x4*)(xin + (size_t)(row0 + ai * HALF + m * 16) * ldc + col0 + bj * HALF);
            asm volatile("" ::: "memory");
#pragma unroll
            for (int m = 0; m < 4; ++m) {
                const int row = row0 + ai * HALF + m * 16; const size_t off = (size_t)row * ldc + col0; float s = 0.f;
#pragma unroll
                for (int bj = 0; bj < 2; ++bj) {
                    const u32x4 xi = xv[m][bj];
                    f32x4 v0 = acc[ai][bj][m][0], v1 = acc[ai][bj][m][1];
                    v0[0] += bflo(xi.x); v0[1] += bfhi(xi.x); v0[2] += bflo(xi.y); v0[3] += bfhi(xi.y); v1[0] += bflo(xi.z); v1[1] += bfhi(xi.z); v1[2] += bflo(xi.w); v1[3] += bfhi(xi.w);
                    s += ((v0[0] * v0[0] + v0[1] * v0[1]) + (v0[2] * v0[2] + v0[3] * v0[3])) + ((v1[0] * v1[0] + v1[1] * v1[1]) + (v1[2] * v1[2] + v1[3] * v1[3]));
                    u32x4 w; w.x = cvtpk(v0[0], v0[1]); w.y = cvtpk(v0[2], v0[3]); w.z = cvtpk(v1[0], v1[1]); w.w = cvtpk(v1[2], v1[3]);
                    *(u32x4*)(x1b + off + bj * HALF) = w;
                }
                s += __shfl_xor(s, 16); s += __shfl_xor(s, 32);
                if (fq == 0) atomicAdd(rss + row, s);
            }
            asm volatile("" ::: "memory");
        }
    }
};

struct EpiX2 {
    static constexpr bool PERM = true, AFTER_DRAIN = false;
    __device__ __forceinline__ bool keep(const Unit&) const { return false; }
    __device__ __forceinline__ void prefetch(const Unit& u, PG8_LAS unsigned char* lds, int tid) const { prefetch_tile_bf16(this->e, ldc, u.pm * BM, u.pn * BM, lds, tid); }
    const bf16_t* x1b; const bf16_t* e; bf16_t* x2b; const float* rss1; float* rss2; int ldc; float eps;
    __device__ __forceinline__ void operator()(const f32x4 (&acc)[2][2][4][2], const Unit& u, int wr, int wc, int fr, int fq) const {
        const int row0 = u.pm * BM + wr * 64 + fr, col0 = u.pn * BM + wc * 32 + 8 * fq;
#pragma unroll
        for (int ai = 0; ai < 2; ++ai) {
            u32x4 xv[4][2], ev[4][2]; float rv[4];
#pragma unroll
            for (int m = 0; m < 4; ++m) { rv[m] = rss1[row0 + ai * HALF + m * 16];
#pragma unroll
                for (int bj = 0; bj < 2; ++bj) { const size_t off = (size_t)(row0 + ai * HALF + m * 16) * ldc + col0 + bj * HALF; xv[m][bj] = *(const u32x4*)(x1b + off); ev[m][bj] = *(const u32x4*)(e + off); } }
            asm volatile("" ::: "memory");
#pragma unroll
            for (int m = 0; m < 4; ++m) {
                const int row = row0 + ai * HALF + m * 16; const size_t off = (size_t)row * ldc + col0; float s = 0.f;
                const float rstd = 1.0f / sqrtf(rv[m] * (1.0f / 1024.0f) + eps);
#pragma unroll
                for (int bj = 0; bj < 2; ++bj) {
                    const u32x4 xi = xv[m][bj], ei = ev[m][bj];
                    const f32x4 a0 = acc[ai][bj][m][0] * rstd, a1 = acc[ai][bj][m][1] * rstd; f32x4 v0, v1;
                    v0[0] = bflo(xi.x) + sigm_f(a0[0]) * bflo(ei.x); v0[1] = bfhi(xi.x) + sigm_f(a0[1]) * bfhi(ei.x); v0[2] = bflo(xi.y) + sigm_f(a0[2]) * bflo(ei.y); v0[3] = bfhi(xi.y) + sigm_f(a0[3]) * bfhi(ei.y);
                    v1[0] = bflo(xi.z) + sigm_f(a1[0]) * bflo(ei.z); v1[1] = bfhi(xi.z) + sigm_f(a1[1]) * bfhi(ei.z); v1[2] = bflo(xi.w) + sigm_f(a1[2]) * bflo(ei.w); v1[3] = bfhi(xi.w) + sigm_f(a1[3]) * bfhi(ei.w);
                    s += ((v0[0] * v0[0] + v0[1] * v0[1]) + (v0[2] * v0[2] + v0[3] * v0[3])) + ((v1[0] * v1[0] + v1[1] * v1[1]) + (v1[2] * v1[2] + v1[3] * v1[3]));
                    u32x4 w; w.x = cvtpk(v0[0], v0[1]); w.y = cvtpk(v0[2], v0[3]); w.z = cvtpk(v1[0], v1[1]); w.w = cvtpk(v1[2], v1[3]);
                    *(u32x4*)(x2b + off + bj * HALF) = w;
                }
                s += __shfl_xor(s, 16); s += __shfl_xor(s, 32);
                if (fq == 0) atomicAdd(rss2 + row, s);
            }
            asm volatile("" ::: "memory");
        }
    }
};
}
constexpr int NWAVES = 8;
#ifndef MK_N_LAUNCHES
#define MK_N_LAUNCHES 1
#endif
constexpr int N_PHASES = 8;
constexpr int N_LAUNCHES = MK_N_LAUNCHES;

constexpr int BATCH = 8, SEQ = 4096, DM = 1024, M = BATCH * SEQ, AW = 512, NH = 8, HD = 64, PLE = 256, NWIN = 6216, NWP = 6400, CK = 31, TOPK = 256;
constexpr int O_Q = 0, O_KI = 2560, O_WI = 2624, O_GLU = 2632, O_ZB = 3656, O_GA = 4168, O_GB = 5192;
constexpr float EPS = 1e-6f;
constexpr int BT_STRIDE = 160;

constexpr size_t MiB = 1u << 20;
constexpr size_t WS_CTL = 0, CTL_ZERO_BYTES = 1 * MiB;
constexpr size_t WS_RS1 = 512 * 1024, WS_RS2 = 768 * 1024;
constexpr size_t WS_WIN = 2 * MiB;
constexpr size_t WS_WBA = 15 * MiB, WS_WBB = 16 * MiB, WS_WOUT = 17 * MiB, WS_WPG = 19 * MiB, WS_WPP = 21 * MiB;
constexpr size_t WS_BIAS = 21 * MiB + 512 * 1024;
constexpr size_t WS_RS0 = 22 * MiB;
constexpr size_t WS_WI = 23 * MiB;
constexpr size_t WS_KI = 24 * MiB;
constexpr size_t WS_MASK = 28 * MiB;
constexpr size_t WS_PB = 44 * MiB;
constexpr size_t WS_XB = 64 * MiB;
constexpr size_t WS_Q = 128 * MiB, WS_K = 160 * MiB, WS_V = 192 * MiB, WS_ZA = 224 * MiB, WS_QI = 256 * MiB, WS_U = 288 * MiB, WS_ZB = 320 * MiB;
constexpr size_t WS_GA = 352 * MiB, WS_GB = 416 * MiB, WS_END = 480 * MiB;
constexpr int CW_BAR = 4096;

constexpr int RING_BYTES = 131072;
constexpr int LDSCTL_OFF = RING_BYTES, MISC_OFF = LDSCTL_OFF + 320;
constexpr int LDS_BYTES = 161792;

#define GAS __attribute__((address_space(1)))
#define LAS __attribute__((address_space(3)))
typedef unsigned short bf16;
typedef unsigned v4u __attribute__((ext_vector_type(4)));
typedef float f32x4 __attribute__((ext_vector_type(4)));
typedef short bf16x8 __attribute__((ext_vector_type(8)));
typedef GAS unsigned gu32;
typedef GAS unsigned long long gu64;
#define RLX_AGENT __ATOMIC_RELAXED, __HIP_MEMORY_SCOPE_AGENT
#define LDS_WAIT() asm volatile("s_waitcnt lgkmcnt(0)" ::: "memory")
#define VM_WAIT() asm volatile("s_waitcnt vmcnt(0)" ::: "memory")
__device__ __forceinline__ unsigned long long rt() { return __builtin_amdgcn_s_memrealtime(); }
__device__ __forceinline__ unsigned f2bf(float f) { unsigned u = __builtin_bit_cast(unsigned, f); return (u + 0x7fffu + ((u >> 16) & 1u)) >> 16; }
__device__ __forceinline__ unsigned pk2(float lo, float hi) { return f2bf(lo) | (f2bf(hi) << 16); }

#define XB_TMO      128
#define XB_XCNT(j)  (256  + 64 * (j))
#define XB_XSUB(j)  (1280 + 64 * (j))
#define XB_XGEN(j)  (2304 + 64 * (j))
#define XB_TOP      3328
#define XB_TOPGEN   3392
#define XCD_BAR_WORDS 3456
#define XB_SPIN_CAP (1u << 18)

__device__ __forceinline__ unsigned xb_ld(unsigned* p)              { return __hip_atomic_load(p, __ATOMIC_RELAXED, __HIP_MEMORY_SCOPE_AGENT); }
__device__ __forceinline__ unsigned xb_add(unsigned* p, unsigned v) { return __hip_atomic_fetch_add(p, v, __ATOMIC_RELAXED, __HIP_MEMORY_SCOPE_AGENT); }
__device__ __forceinline__ unsigned xb_xcc_id() { return (unsigned)__builtin_amdgcn_s_getreg((3 << 11) | 20) & 0xFu; }
#define XB_SPIN(cond, bar) do { unsigned _sp = 0; while (cond) { __builtin_amdgcn_s_sleep(1); \
    if ((++_sp & 255u) == 0u) { if (xb_ld(&(bar)[XB_TMO])) break; if (_sp > XB_SPIN_CAP) { atomicAdd(&(bar)[XB_TMO], 1u); break; } } } } while (0)

struct XcdBarrier {
    unsigned* bar; unsigned x;
    volatile LAS unsigned* st;
};

__device__ __forceinline__ XcdBarrier xcd_barrier_post(unsigned* bar, volatile LAS unsigned* st) {
    XcdBarrier b; b.bar = bar; b.x = xb_xcc_id(); b.st = st;
    if (threadIdx.x == 0) (void)xb_add(&bar[XB_XCNT(b.x)], 1u);
    return b;
}
__device__ __forceinline__ void xcd_barrier_complete(unsigned* bar, unsigned x, unsigned& nloc, unsigned& nx) {
    const unsigned G = gridDim.x * gridDim.y * gridDim.z;
    unsigned sum, cnt, mine, sp = 0u;
    for (;;) {
        sum = 0u; cnt = 0u; mine = 0u;
#pragma unroll
        for (unsigned j = 0; j < 16; ++j) { const unsigned c = xb_ld(&bar[XB_XCNT(j)]); sum += c; cnt += (c > 0u) ? 1u : 0u; mine = (j == x) ? c : mine; }
        if (sum == G) break;
        __builtin_amdgcn_s_sleep(1);
        if ((++sp & 255u) == 0u) { if (xb_ld(&bar[XB_TMO])) break; if (sp > XB_SPIN_CAP) { atomicAdd(&bar[XB_TMO], 1u); break; } }
    }
    nloc = mine > 0u ? mine : 1u; nx = cnt > 0u ? cnt : 1u;
}

__device__ __forceinline__ void xcd_barrier(const XcdBarrier& b) {
    asm volatile("s_waitcnt vmcnt(0)" ::: "memory");
    __syncthreads();
    if (threadIdx.x == 0) {
        unsigned* bar = b.bar;
        __builtin_amdgcn_s_waitcnt(0);
        unsigned nloc = b.st[0], nx = b.st[1];
        if (nloc == 0u) { xcd_barrier_complete(bar, b.x, nloc, nx); b.st[0] = nloc; b.st[1] = nx; }
        const unsigned old = xb_add(&bar[XB_XSUB(b.x)], 1u);
        const unsigned gen = old / nloc;
        if (old + 1u == (gen + 1u) * nloc) {
            __builtin_amdgcn_fence(__ATOMIC_RELEASE, "agent");
            asm volatile("s_waitcnt vmcnt(0)" ::: "memory");
            const unsigned og = xb_add(&bar[XB_TOP], 1u);
            const unsigned tg = og / nx;
            if (og + 1u == (tg + 1u) * nx) xb_add(&bar[XB_TOPGEN], 1u);
            else XB_SPIN(xb_ld(&bar[XB_TOPGEN]) == tg, bar);
            __builtin_amdgcn_fence(__ATOMIC_ACQUIRE, "agent");
            xb_add(&bar[XB_XGEN(b.x)], 1u);
            asm volatile("s_waitcnt vmcnt(0)" ::: "memory");
        } else {
            XB_SPIN(xb_ld(&bar[XB_XGEN(b.x)]) == gen, bar);
            __builtin_amdgcn_fence(__ATOMIC_ACQUIRE, "agent");
            asm volatile("s_waitcnt vmcnt(0)" ::: "memory");
        }
    }
    __syncthreads();
}
struct Args {
    const float *x, *p, *norm_in_g, *w_in, *conv_w, *conv_b, *conv_ln_g, *conv_ln_b, *w_ba, *w_bb, *w_out, *ple_g, *w_pg, *w_pp, *rel_bias, *fin_g;
    float* out; unsigned char* ws; int ph_lo, ph_hi;
};
typedef float f32x16 __attribute__((ext_vector_type(16)));
typedef unsigned u32x2 __attribute__((ext_vector_type(2)));
__device__ __forceinline__ unsigned cvtpk2(float lo, float hi) { return pg8::cvtpk(lo, hi); }
__device__ __forceinline__ float bf2f(unsigned short h) { return __uint_as_float(((unsigned)h) << 16); }
__device__ __forceinline__ float wave_sum(float v) {
#pragma unroll
    for (int o = 1; o < 64; o <<= 1) v += __shfl_xor(v, o);
    return v;
}
__device__ __forceinline__ int t5_bucket(int rel) {
    const int base = rel > 0 ? 16 : 0; const int n = rel < 0 ? -rel : rel; int v;
    if (n < 8) v = n; else if (n < 12) v = 8; else if (n < 16) v = 9; else if (n < 23) v = 10; else if (n < 32) v = 11; else if (n < 46) v = 12; else if (n < 64) v = 13; else if (n < 91) v = 14; else v = 15;
    return base + v;
}
__device__ __forceinline__ unsigned mono_key(float f) { const unsigned u = __float_as_uint(f); return u ^ ((unsigned)((int)u >> 31) | 0x80000000u); }
__device__ __forceinline__ float relu_i(float x) { const int b = (int)__float_as_uint(x); return __uint_as_float((unsigned)(b > 0 ? b : 0)); }
__device__ __forceinline__ float unmono_key(unsigned k) { return __uint_as_float((k & 0x80000000u) ? (k & 0x7fffffffu) : ~k); }

__device__ __forceinline__ void p0_item(const float* W, int K, int Nsrc, int scol0, int nvalid, const float* g, bf16* WT, int drow0, int k0, LAS float* scr, int lane) {
    const int j = lane & 31, jv = j < nvalid ? j : 0; const float msk = j < nvalid ? 1.f : 0.f;
    const float* wp = W + (size_t)(k0 + (lane >> 5)) * Nsrc + scol0 + jv;
    float v[32];
#pragma unroll
    for (int i = 0; i < 32; ++i) v[i] = wp[(size_t)(2 * i) * Nsrc];
    const int c = lane & 7;
    f32x4 g0 = {1.f, 1.f, 1.f, 1.f}, g1 = g0;
    if (g) { g0 = *(const GAS f32x4*)(g + k0 + 8 * c); g1 = *(const GAS f32x4*)(g + k0 + 8 * c + 4); }
#pragma unroll
    for (int i = 0; i < 32; ++i) scr[(2 * i + (lane >> 5)) * 33 + j] = v[i] * msk;
    LDS_WAIT(); asm volatile("" ::: "memory");
#pragma unroll
    for (int jj = 0; jj < 4; ++jj) { const int n = (lane >> 3) + 8 * jj; const LAS float* s = scr + (8 * c) * 33 + n;
        v4u o; o.x = pk2(s[0 * 33] * g0[0], s[1 * 33] * g0[1]); o.y = pk2(s[2 * 33] * g0[2], s[3 * 33] * g0[3]); o.z = pk2(s[4 * 33] * g1[0], s[5 * 33] * g1[1]); o.w = pk2(s[6 * 33] * g1[2], s[7 * 33] * g1[3]);
        *(GAS v4u*)(WT + (size_t)(drow0 + n) * K + k0 + 8 * c) = o; }
    LDS_WAIT(); asm volatile("" ::: "memory");
}
__device__ __forceinline__ void win_block(int db, int& scol0, int& nvalid) {
    const int pn = db >> 3, sub = db & 7; nvalid = 32;
    if (pn < 10) scol0 = pn * 256 + sub * 32;
    else if (pn < 14) scol0 = O_GLU + (pn - 10) * 128 + (sub < 4 ? sub * 32 : 512 + (sub - 4) * 32);
    else if (pn < 16) scol0 = O_ZB + (pn - 14) * 256 + sub * 32;
    else if (pn < 20) scol0 = O_GA + (pn - 16) * 256 + sub * 32;
    else if (pn < 24) scol0 = O_GB + (pn - 20) * 256 + sub * 32;
    else { if (sub < 2) scol0 = O_KI + sub * 32; else if (sub == 2) { scol0 = O_WI; nvalid = 8; } else { scol0 = 0; nvalid = 0; } }
}
__device__ __forceinline__ void p0_prologue(const Args& A, LAS unsigned char* lds, int vcu, int G) {
    const int tid = threadIdx.x, lane = tid & 63, wave = __builtin_amdgcn_readfirstlane(tid >> 6);
    unsigned char* ws = A.ws;
    LAS float* scr = (LAS float*)(lds + wave * 16384);
    const bool itemw = wave >= 4;
    const int gw = itemw ? vcu * 4 + (wave - 4) : vcu * 4 + wave, NGW = G * 4;
    constexpr int I_IN = 200 * 16, I_BA = 32 * 8, I_BB = 32 * 8, I_OUT = 32 * 16, I_PG = 32 * 16, I_PP = 32 * 4;
    constexpr int NITEMS = I_IN + I_BA + I_BB + I_OUT + I_PG + I_PP;
    if (itemw) for (int it = gw; it < NITEMS; it += NGW) {
        int r = it; const float* W; const float* gsc = nullptr; bf16* WT; int K, Nsrc, sc0, nv = 32, drow0, k0;
        if (r < I_IN) { const int db = r >> 4; win_block(db, sc0, nv); W = A.w_in; K = DM; Nsrc = NWIN; gsc = A.norm_in_g; WT = (bf16*)(ws + WS_WIN); drow0 = db * 32; k0 = (r & 15) * 64; }
        else if ((r -= I_IN) < I_BA) { W = A.w_ba; K = AW; Nsrc = DM; sc0 = (r >> 3) * 32; WT = (bf16*)(ws + WS_WBA); drow0 = sc0; k0 = (r & 7) * 64; }
        else if ((r -= I_BA) < I_BB) { W = A.w_bb; K = AW; Nsrc = DM; sc0 = (r >> 3) * 32; WT = (bf16*)(ws + WS_WBB); drow0 = sc0; k0 = (r & 7) * 64; }
        else if ((r -= I_BB) < I_OUT) { W = A.w_out; K = DM; Nsrc = DM; sc0 = (r >> 4) * 32; WT = (bf16*)(ws + WS_WOUT); drow0 = sc0; k0 = (r & 15) * 64; }
        else if ((r -= I_OUT) < I_PG) { W = A.w_pg; K = DM; Nsrc = DM; sc0 = (r >> 4) * 32; gsc = A.ple_g; WT = (bf16*)(ws + WS_WPG); drow0 = sc0; k0 = (r & 15) * 64; }
        else { r -= I_PG; W = A.w_pp; K = PLE; Nsrc = DM; sc0 = (r >> 2) * 32; WT = (bf16*)(ws + WS_WPP); drow0 = sc0; k0 = (r & 3) * 64; }
        p0_item(W, K, Nsrc, sc0, nv, gsc, WT, drow0, k0, scr, lane);
    }
#ifdef MK_PROBE_A
    if (blockIdx.x == 0 && tid == 0) ((unsigned long long*)(ws + WS_CTL + 256 * 1024))[30] = rt();
#endif
    bf16* XB = (bf16*)(ws + WS_XB); float* RS0 = (float*)(ws + WS_RS0); bf16* PB = (bf16*)(ws + WS_PB);
    if (!itemw) for (int m0 = gw * 4; m0 < M; m0 += NGW * 4) {
        f32x4 v[4][4], pv[4]; float s[4];
#pragma unroll
        for (int r = 0; r < 4; ++r) { const GAS f32x4* xr = (const GAS f32x4*)(A.x + (size_t)(m0 + r) * DM) + lane;
#pragma unroll
            for (int j = 0; j < 4; ++j) v[r][j] = __builtin_nontemporal_load(xr + 64 * j);
            pv[r] = __builtin_nontemporal_load((const GAS f32x4*)(A.p + (size_t)(m0 + r) * PLE) + lane); }
#pragma unroll
        for (int r = 0; r < 4; ++r) { float t = 0.f;
#pragma unroll
            for (int j = 0; j < 4; ++j) t += (v[r][j].x * v[r][j].x + v[r][j].y * v[r][j].y) + (v[r][j].z * v[r][j].z + v[r][j].w * v[r][j].w);
            s[r] = t; }
#pragma unroll
        for (int o = 1; o < 64; o <<= 1) {
#pragma unroll
            for (int r = 0; r < 4; ++r) s[r] += __shfl_xor(s[r], o); }
#pragma unroll
        for (int r = 0; r < 4; ++r) {
            if (lane == 0) RS0[m0 + r] = 1.0f / sqrtf(s[r] * (1.0f / DM) + EPS);
            GAS u32x2* o8 = (GAS u32x2*)(XB + (size_t)(m0 + r) * DM) + lane;
#pragma unroll
            for (int j = 0; j < 4; ++j) { u32x2 w; w.x = cvtpk2(v[r][j].x, v[r][j].y); w.y = cvtpk2(v[r][j].z, v[r][j].w); o8[64 * j] = w; }
            u32x2 w; w.x = cvtpk2(pv[r].x, pv[r].y); w.y = cvtpk2(pv[r].z, pv[r].w);
            ((GAS u32x2*)(PB + (size_t)(m0 + r) * PLE))[lane] = w;
        }
    }
#ifdef MK_PROBE_A
    if (blockIdx.x == 0 && tid == 0) ((unsigned long long*)(ws + WS_CTL + 256 * 1024))[31] = rt();
#endif
    if (vcu == 0) {
        float* BTg = (float*)(ws + WS_BIAS);
        for (int i = tid; i < NH * BT_STRIDE; i += NWAVES * 64) { const int h = i / BT_STRIDE, k = i % BT_STRIDE; const int rel = k - 91; const int bk = t5_bucket(rel < 64 ? rel : 63);
            BTg[i] = (A.rel_bias[bk * NH + h] - A.rel_bias[15 * NH + h]) * 1.4426950408889634f; }
    }
}

__device__ __forceinline__ void conv_phase(const Args& A, LAS unsigned char* lds, int vcu, int G) {
    const int tid = threadIdx.x, lane = tid & 63, wave = __builtin_amdgcn_readfirstlane(tid >> 6);
    const bf16* U = (const bf16*)(A.ws + WS_U); bf16* ZB = (bf16*)(A.ws + WS_ZB);
    LAS float* Y = (LAS float*)(lds + 65536);
    const int c = tid;
    float w[CK];
#pragma unroll
    for (int j = 0; j < CK; ++j) w[j] = A.conv_w[j * 512 + c];
    const float cb = A.conv_b[c];
    f32x4 lg0 = *(const GAS f32x4*)(A.conv_ln_g + 8 * lane), lg1 = *(const GAS f32x4*)(A.conv_ln_g + 8 * lane + 4);
    f32x4 lb0 = *(const GAS f32x4*)(A.conv_ln_b + 8 * lane), lb1 = *(const GAS f32x4*)(A.conv_ln_b + 8 * lane + 4);
    for (int tile = vcu; tile < M / 32; tile += G) {
        const int t0 = tile * 32, pos0 = t0 & (SEQ - 1);
        {
            v4u uv[8];
#pragma unroll
            for (int i = 0; i < 8; ++i) { const int id = tid + 512 * i, row = id >> 6, ch = id & 63; const int rr = (pos0 - 30 + row >= 0 && id < 62 * 64) ? row : 30;
                uv[i] = *(const GAS v4u*)(U + (size_t)(t0 - 30 + rr) * 512 + ch * 8); }
#pragma unroll
            for (int i = 0; i < 8; ++i) { const int id = tid + 512 * i, row = id >> 6, ch = id & 63;
                if (id < 62 * 64) { const v4u z = {0u, 0u, 0u, 0u}; *(LAS v4u*)(lds + row * 1024 + ch * 16) = (pos0 - 30 + row >= 0) ? uv[i] : z; } }
        }
        __syncthreads();
        {
            float uu[62];
#pragma unroll
            for (int i = 0; i < 62; ++i) uu[i] = bf2f(*(const LAS unsigned short*)(lds + i * 1024 + c * 2));
#pragma unroll
            for (int t = 0; t < 32; ++t) { float a = cb;
#pragma unroll
                for (int j = 0; j < CK; ++j) a = fmaf(w[j], uu[t + j], a);
                Y[t * 512 + c] = a; }
        }
        __syncthreads();
        v4u zwv[4];
#pragma unroll
        for (int tt = 0; tt < 4; ++tt) zwv[tt] = *(const GAS v4u*)(ZB + (size_t)(t0 + wave * 4 + tt) * 512 + 8 * lane);
        asm volatile("" ::: "memory");
#pragma unroll
        for (int tt = 0; tt < 4; ++tt) {
            const int t = wave * 4 + tt;
            const f32x4 y0 = *(const LAS f32x4*)(Y + t * 512 + 8 * lane), y1 = *(const LAS f32x4*)(Y + t * 512 + 8 * lane + 4);
            const v4u zw = zwv[tt];
            float s1 = (y0[0] + y0[1]) + (y0[2] + y0[3]) + (y1[0] + y1[1]) + (y1[2] + y1[3]);
            float s2 = (y0[0] * y0[0] + y0[1] * y0[1]) + (y0[2] * y0[2] + y0[3] * y0[3]) + (y1[0] * y1[0] + y1[1] * y1[1]) + (y1[2] * y1[2] + y1[3] * y1[3]);
#pragma unroll
            for (int o = 1; o < 64; o <<= 1) { s1 += __shfl_xor(s1, o); s2 += __shfl_xor(s2, o); }
            const float mu = s1 * (1.0f / 512.0f); float var = s2 * (1.0f / 512.0f) - mu * mu; var = var > 0.f ? var : 0.f;
            const float rs = 1.0f / sqrtf(var + EPS);
            float o_[8];
#pragma unroll
            for (int e = 0; e < 4; ++e) { const float v0 = (y0[e] - mu) * rs * lg0[e] + lb0[e], v1 = (y1[e] - mu) * rs * lg1[e] + lb1[e]; o_[e] = v0 * pg8::sigm_f(v0); o_[4 + e] = v1 * pg8::sigm_f(v1); }
            v4u ow; ow.x = cvtpk2(o_[0] * pg8::bflo(zw.x), o_[1] * pg8::bfhi(zw.x)); ow.y = cvtpk2(o_[2] * pg8::bflo(zw.y), o_[3] * pg8::bfhi(zw.y));
            ow.z = cvtpk2(o_[4] * pg8::bflo(zw.z), o_[5] * pg8::bfhi(zw.z)); ow.w = cvtpk2(o_[6] * pg8::bflo(zw.w), o_[7] * pg8::bfhi(zw.w));
            *(GAS v4u*)(ZB + (size_t)(t0 + t) * 512 + 8 * lane) = ow;
        }
        __syncthreads();
    }
}

#define IDX_SECTION(J0, BODY) if (nj > (J0)) { _Pragma("unroll") for (int j = (J0); j < (J0) + 16; ++j) { BODY } }
#define IDX_FORALL(BODY) do { IDX_SECTION(0, BODY) IDX_SECTION(16, BODY) IDX_SECTION(32, BODY) IDX_SECTION(48, BODY) } while (0)
constexpr int IDX_NB = 256;
constexpr int IDX_HIST_OFF = 132096, IDX_CAND_OFF = IDX_HIST_OFF + 8 * IDX_NB * 4, IDX_QST_OFF = IDX_CAND_OFF + 8 * 128 * 4, IDX_QST_BYTES = 8192 + 256;
static_assert(IDX_QST_OFF + 2 * IDX_QST_BYTES <= LDS_BYTES, "indexer LDS map");
__device__ __forceinline__ void idx_group(int it, int vcu, int G, int& b, int& jg) { if (G == 256) { b = it >> 1; jg = (it & 1) ? 511 - vcu : vcu; } else { const int idx = it * G + vcu; b = idx >> 9; jg = idx & 511; } }
__device__ __forceinline__ void idx_phase(const Args& A, LAS unsigned char* lds, int vcu, int G) {
    const int tid = threadIdx.x, lane = tid & 63, wid = __builtin_amdgcn_readfirstlane(tid >> 6), r32 = lane & 31, hi = lane >> 5;
    const bf16* QI = (const bf16*)(A.ws + WS_QI); const bf16* KI = (const bf16*)(A.ws + WS_KI); const float* WI = (const float*)(A.ws + WS_WI);
    unsigned long long* MASK = (unsigned long long*)(A.ws + WS_MASK);
    LAS unsigned* S = (LAS unsigned*)lds;
    LAS unsigned* HIST = (LAS unsigned*)(lds + IDX_HIST_OFF);
    LAS unsigned* CAND = (LAS unsigned*)(lds + IDX_CAND_OFF) + wid * 128;
    const int ngroups = M / 8; const int nit = (ngroups - vcu + G - 1) / G;
    const int qloc = 2 * ((r32 >> 2) & 1) + (r32 >> 4), hrow = 4 * ((r32 >> 3) & 1) + (r32 & 3);
    for (int i = tid; i < 8 * IDX_NB; i += NWAVES * 64) HIST[i] = 0u;
    v4u nqv = {0u, 0u, 0u, 0u}; f32x4 nwv = {0.f, 0.f, 0.f, 0.f};
    if (nit > 0) { int b0_, j0_; idx_group(0, vcu, G, b0_, j0_); const size_t g0 = (size_t)(b0_ * SEQ + j0_ * 8);
        *(LAS v4u*)(lds + IDX_QST_OFF + tid * 16) = *(const GAS v4u*)(QI + g0 * 512 + tid * 8);
        if (tid < 16) *(LAS f32x4*)(lds + IDX_QST_OFF + 8192 + tid * 16) = *(const GAS f32x4*)(WI + g0 * 8 + tid * 4); }
    if (nit > 1) { int b1_, j1_; idx_group(1, vcu, G, b1_, j1_); const size_t g1 = (size_t)(b1_ * SEQ + j1_ * 8);
        nqv = *(const GAS v4u*)(QI + g1 * 512 + tid * 8); if (tid < 16) nwv = *(const GAS f32x4*)(WI + g1 * 8 + tid * 4); }
    __syncthreads();
    for (int it = 0; it < nit; ++it) {
        int b, jg; idx_group(it, vcu, G, b, jg);
        const int pos0 = jg * 8, q0 = b * SEQ + pos0, n = ((pos0 >> 6) + 1) * 64, nj = n >> 6;
        const bool trivial = n <= TOPK;
        if (!trivial) {
            LAS unsigned char* QST = lds + IDX_QST_OFF + (it & 1) * IDX_QST_BYTES; LAS float* WST = (LAS float*)(QST + 8192);
            bf16x8 afr[2][4]; float wv[2][2][8];
#pragma unroll
            for (int g = 0; g < 2; ++g) {
#pragma unroll
                for (int s = 0; s < 4; ++s) afr[g][s] = *(const LAS bf16x8*)(QST + (4 * g + qloc) * 1024 + hrow * 128 + s * 32 + hi * 16);
#pragma unroll
                for (int i = 0; i < 2; ++i) { const LAS f32x4* wp = (const LAS f32x4*)(WST + (4 * g + 2 * hi + i) * 8); const f32x4 w0 = wp[0], w1 = wp[1];
                    wv[g][i][0] = w0[0]; wv[g][i][1] = w0[1]; wv[g][i][2] = w0[2]; wv[g][i][3] = w0[3]; wv[g][i][4] = w1[0]; wv[g][i][5] = w1[1]; wv[g][i][6] = w1[2]; wv[g][i][7] = w1[3]; }
            }
            const int nblk = n >> 5;
            const bf16* KIb = KI + (size_t)(b * (SEQ / 32)) * 2048 + (hi * 32 + r32) * 8;
#define IDX_LOADK(dst, blk_) do { const int bb_ = (blk_) < nblk ? (blk_) : nblk - 1; const bf16* kp_ = KIb + (size_t)bb_ * 2048; \
        _Pragma("unroll") for (int s = 0; s < 4; ++s) dst[s] = *(const GAS bf16x8*)(kp_ + 512 * s); } while (0)
#define IDX_PUT(row_, key_, sc_) do { S[(row_) * 4096 + (key_)] = mono_key(sc_); const float s32_ = (sc_) * 32.0f; int bk_; asm("v_cvt_flr_i32_f32 %0, %1" : "=v"(bk_) : "v"(s32_)); bk_ += IDX_NB / 2; bk_ = bk_ < 0 ? 0 : (bk_ > IDX_NB - 1 ? IDX_NB - 1 : bk_); \
        __hip_atomic_fetch_add(HIST + (row_) * IDX_NB + bk_, 1u, __ATOMIC_RELAXED, __HIP_MEMORY_SCOPE_WORKGROUP); } while (0)
#define IDX_COMP(src, blk_) do { if ((blk_) < nblk) { _Pragma("unroll") for (int g = 0; g < 2; ++g) { \
            f32x16 acc = {0.f, 0.f, 0.f, 0.f, 0.f, 0.f, 0.f, 0.f, 0.f, 0.f, 0.f, 0.f, 0.f, 0.f, 0.f, 0.f}; \
            _Pragma("unroll") for (int s = 0; s < 4; ++s) acc = __builtin_amdgcn_mfma_f32_32x32x16_bf16(afr[g][s], src[s], acc, 0, 0, 0); \
            float s0 = 0.f, s1 = 0.f; \
            _Pragma("unroll") for (int r = 0; r < 8; ++r) { s0 = fmaf(relu_i(acc[r]), wv[g][0][r], s0); s1 = fmaf(relu_i(acc[8 + r]), wv[g][1][r], s1); } \
            IDX_PUT(4 * g + 2 * hi, (blk_) * 32 + r32, s0); IDX_PUT(4 * g + 2 * hi + 1, (blk_) * 32 + r32, s1); } } } while (0)
            bf16x8 kb0[4], kb1[4], kb2[4], kb3[4];
            IDX_LOADK(kb0, wid); IDX_LOADK(kb1, wid + 8); IDX_LOADK(kb2, wid + 16);
            for (int blk = wid; blk < nblk; blk += 32) {
                IDX_LOADK(kb3, blk + 24); IDX_COMP(kb0, blk);
                IDX_LOADK(kb0, blk + 32); IDX_COMP(kb1, blk + 8);
                IDX_LOADK(kb1, blk + 40); IDX_COMP(kb2, blk + 16);
                IDX_LOADK(kb2, blk + 48); IDX_COMP(kb3, blk + 24);
            }
#undef IDX_LOADK
#undef IDX_COMP
#undef IDX_PUT
        }
        __syncthreads();
        unsigned uk[64]; v4u h0 = {0u, 0u, 0u, 0u};
#pragma unroll
        for (int j = 0; j < 64; ++j) uk[j] = 0u;
        if (!trivial) {
            LAS v4u* H4 = (LAS v4u*)(HIST + wid * IDX_NB) + lane; h0 = H4[0]; const v4u z4 = {0u, 0u, 0u, 0u}; H4[0] = z4;
            LAS unsigned* Sr = S + wid * 4096 + lane;
            { const int jend = (nj + 15) & ~15; for (int jj = nj; jj < jend; ++jj) Sr[64 * jj] = 0u; }
            IDX_FORALL(uk[j] = Sr[64 * j];);
        }
        if (it + 1 < nit) { LAS unsigned char* QN = lds + IDX_QST_OFF + ((it + 1) & 1) * IDX_QST_BYTES; *(LAS v4u*)(QN + tid * 16) = nqv; if (tid < 16) *(LAS f32x4*)(QN + 8192 + tid * 16) = nwv; }
        if (it + 2 < nit) { int b2_, j2_; idx_group(it + 2, vcu, G, b2_, j2_); const size_t g2 = (size_t)(b2_ * SEQ + j2_ * 8);
            nqv = *(const GAS v4u*)(QI + g2 * 512 + tid * 8); if (tid < 16) nwv = *(const GAS f32x4*)(WI + g2 * 8 + tid * 4); }
        asm volatile("s_waitcnt lgkmcnt(0)" ::: "memory");
        __builtin_amdgcn_s_barrier();
        asm volatile("" ::: "memory");
        if (trivial) { MASK[((size_t)(b * 64 + lane) << 12) + pos0 + wid] = lane < nj ? ~0ull : 0ull; continue; }
        {
            int bstar, cabove, cntb;
            {
                const int sl = (int)((h0.x + h0.y) + (h0.z + h0.w));
                int incl = sl;
#pragma unroll
                for (int o = 1; o < 64; o <<= 1) { const int t_ = __shfl_down(incl, o); incl += (lane + o < 64) ? t_ : 0; }
                const int above = incl - sl;
                const unsigned long long pm = __builtin_amdgcn_ballot_w64(above < TOPK && incl >= TOPK);
                const int lsel = (int)__builtin_ctzll(pm | (1ull << 63));
                int abv = __builtin_amdgcn_readlane(above, lsel);
                const int bn0 = __builtin_amdgcn_readlane((int)h0.x, lsel), bn1 = __builtin_amdgcn_readlane((int)h0.y, lsel), bn2 = __builtin_amdgcn_readlane((int)h0.z, lsel), bn3 = __builtin_amdgcn_readlane((int)h0.w, lsel);
                int kk = 3; cntb = bn3;
                if (abv + cntb < TOPK) { abv += cntb; kk = 2; cntb = bn2;
                if (abv + cntb < TOPK) { abv += cntb; kk = 1; cntb = bn1;
                if (abv + cntb < TOPK) { abv += cntb; kk = 0; cntb = bn0; } } }
                bstar = 4 * lsel + kk; cabove = abv;
            }
            const unsigned lo_key = bstar == 0 ? 1u : mono_key((float)(bstar - IDX_NB / 2) * (1.0f / 32.0f));
            const unsigned hi_key = bstar == IDX_NB - 1 ? 0xffffffffu : mono_key((float)(bstar - IDX_NB / 2 + 1) * (1.0f / 32.0f));
            unsigned L = lo_key, H = hi_key; int cH = cabove; bool exact = false; unsigned T = 0u;
            if (cntb <= 128) {
                const unsigned wdt = hi_key - lo_key; int base = 0;
                IDX_FORALL(const bool pr = (uk[j] - lo_key) < wdt; const unsigned long long bm = __builtin_amdgcn_ballot_w64(pr);
                           if (bm) { const int ps = base + (int)__builtin_amdgcn_mbcnt_hi((unsigned)(bm >> 32), __builtin_amdgcn_mbcnt_lo((unsigned)bm, 0u));
                                     if (pr) CAND[ps & 127] = uk[j]; base += __builtin_popcountll(bm); });
                const unsigned ck0 = (lane < cntb) ? CAND[lane] : 0u, ck1 = (lane + 64 < cntb) ? CAND[lane + 64] : 0u;
                const int r = TOPK - cabove;
                unsigned l2 = lo_key, h2 = hi_key;
                while (h2 - l2 > 1u) { const unsigned md = l2 + ((h2 - l2) >> 1); const int c = __builtin_popcountll(__builtin_amdgcn_ballot_w64(ck0 >= md)) + __builtin_popcountll(__builtin_amdgcn_ballot_w64(ck1 >= md)); if (c >= r) l2 = md; else h2 = md; }
                const int cge = __builtin_popcountll(__builtin_amdgcn_ballot_w64(ck0 >= l2)) + __builtin_popcountll(__builtin_amdgcn_ballot_w64(ck1 >= l2));
                if (cge == r) { exact = true; T = l2; } else { L = l2; H = l2 + 1u; cH = cabove + __builtin_popcountll(__builtin_amdgcn_ballot_w64(ck0 > l2)) + __builtin_popcountll(__builtin_amdgcn_ballot_w64(ck1 > l2)); }
            }
            for (int iter = 0; !exact && iter < 96 && H - L > 1u; ++iter) {
                unsigned mid = L + ((H - L) >> 1);
                if (iter < 24) { const float fm = 0.5f * (unmono_key(L) + unmono_key(H)); const unsigned km = mono_key(fm); if (km > L && km < H) mid = km; }
                mid = (unsigned)__builtin_amdgcn_readfirstlane((int)mid);
                int ca = 0, cb = 0;
                IDX_FORALL(if (j & 1) cb += (uk[j] >= mid) ? 1 : 0; else ca += (uk[j] >= mid) ? 1 : 0;);
                ca += cb; int c = 0;
#pragma unroll
                for (int bt = 0; bt < 7; ++bt) c += __builtin_popcountll(__builtin_amdgcn_ballot_w64(((ca >> bt) & 1) != 0)) << bt;
                if (c == TOPK) { T = mid; exact = true; break; }
                if (c > TOPK) L = mid; else { H = mid; cH = c; }
            }
            unsigned wlo = 0u, whi = 0u;
            int lane_o = lane; asm volatile("" : "+v"(lane_o));
            if (exact) {
                IDX_FORALL(const unsigned long long bm = __builtin_amdgcn_ballot_w64(uk[j] >= T); if (lane_o == j) { wlo = (unsigned)bm; whi = (unsigned)(bm >> 32); });
            } else {
                const int need = TOPK - cH; int run = 0;
                IDX_FORALL(const bool eq = uk[j] == L; const unsigned long long be = __builtin_amdgcn_ballot_w64(eq);
                           const int rk = run + (int)__builtin_amdgcn_mbcnt_hi((unsigned)(be >> 32), __builtin_amdgcn_mbcnt_lo((unsigned)be, 0u));
                           const bool sel = (uk[j] > L) || (eq && rk < need);
                           const unsigned long long bm = __builtin_amdgcn_ballot_w64(sel); run += __builtin_popcountll(be);
                           if (lane_o == j) { wlo = (unsigned)bm; whi = (unsigned)(bm >> 32); });
            }
            MASK[((size_t)(b * 64 + lane) << 12) + pos0 + wid] = ((unsigned long long)whi << 32) | wlo;
        }
    }
    __syncthreads();
}
#undef IDX_SECTION
#undef IDX_FORALL

__device__ __forceinline__ void attn_phase(const Args& A, LAS unsigned char* lds, int vcu, int G) {
    const int tid = threadIdx.x, lane = tid & 63, wid = __builtin_amdgcn_readfirstlane(tid >> 6), r32 = lane & 31, hi = lane >> 5;
    bf16* Qb = (bf16*)(A.ws + WS_Q); const bf16* Kg = (const bf16*)(A.ws + WS_K); const bf16* Vg = (const bf16*)(A.ws + WS_V); const bf16* ZA = (const bf16*)(A.ws + WS_ZA);
    const unsigned long long* MASK = (const unsigned long long*)(A.ws + WS_MASK);
    constexpr int KB0 = 0, VT0 = 16384, VP = 192, VTB = 64 * VP, BTO = VT0 + 2 * VTB;
    LAS float* BT = (LAS float*)(lds + BTO);
    { const float* BTg = (const float*)(A.ws + WS_BIAS); for (int i = tid; i < NH * BT_STRIDE; i += NWAVES * 64) BT[i] = BTg[i]; }
    __syncthreads();
    const int lkv = tid >> 3, lch = tid & 7;
    const int kst = lkv * 128 + ((lch ^ ((lkv >> 1) & 7)) << 4), vst = lkv * VP + lch * 16;
    const int vrd = (4 * hi + ((lane & 15) >> 2)) * VP + (16 * ((lane >> 4) & 1) + 4 * (lane & 3)) * 2;
    const int nunits = BATCH * NH * (SEQ / 256);
    for (int iu = 0;; ++iu) {
        const int ui = iu * G + vcu; if (ui >= nunits) break;
        int bh, qb;
        if (G == 256) { bh = vcu >> 2; const int s = vcu & 3; qb = (iu == 0) ? s : (iu == 1) ? 7 - s : (iu == 2) ? 8 + s : 15 - s; } else { bh = ui >> 4; qb = ui & 15; }
        const int b = bh >> 3, h = bh & 7, q0 = qb * 256, tokb = b * SEQ, NT = 4 * qb + 4, cw = 4 * qb + (wid >> 1);
        const int myq = q0 + 32 * wid + r32; const size_t tokq = (size_t)(tokb + myq);
        bf16x8 qf[4];
#pragma unroll
        for (int d0 = 0; d0 < 4; ++d0) qf[d0] = *(const GAS bf16x8*)(Qb + tokq * 512 + h * 64 + 16 * d0 + 8 * hi);
        float m = 0.f, l = 0.f;
        f32x16 ot0 = {0.f, 0.f, 0.f, 0.f, 0.f, 0.f, 0.f, 0.f, 0.f, 0.f, 0.f, 0.f, 0.f, 0.f, 0.f, 0.f}, ot1 = ot0;
        const bf16* kptr = Kg + (size_t)(tokb + lkv) * 512 + h * 64 + lch * 8;
        const bf16* vptr = Vg + (size_t)(tokb + lkv) * 512 + h * 64 + lch * 8;
        v4u kr = *(const GAS v4u*)kptr, vr = *(const GAS v4u*)vptr;
#define ATT_WRITE(buf) do { *(LAS v4u*)(lds + KB0 + (buf) * 8192 + kst) = kr; *(LAS v4u*)(lds + VT0 + (buf) * VTB + vst) = vr; } while (0)
        ATT_WRITE(0);
        if (NT > 1) { kr = *(const GAS v4u*)(kptr + (size_t)64 * 512); vr = *(const GAS v4u*)(vptr + (size_t)64 * 512); }
        const unsigned long long* mrow = MASK + ((size_t)(b * 64) << 12) + myq;
        unsigned long long mw = mrow[0];
        f32x16 nm = {0.f, 0.f, 0.f, 0.f, 0.f, 0.f, 0.f, 0.f, 0.f, 0.f, 0.f, 0.f, 0.f, 0.f, 0.f, 0.f};
        __syncthreads();
        for (int t = 0; t < NT; ++t) {
            const int cur = t & 1;
            unsigned mlo = (unsigned)mw >> (4 * hi), mhi = (unsigned)(mw >> 32) >> (4 * hi);
            asm volatile("" : "+v"(mlo), "+v"(mhi) :: "memory");
            if (t + 1 < NT) ATT_WRITE(cur ^ 1);
            asm volatile("" ::: "memory");
            if (t + 2 < NT) { kr = *(const GAS v4u*)(kptr + (size_t)(t + 2) * 64 * 512); vr = *(const GAS v4u*)(vptr + (size_t)(t + 2) * 64 * 512); }
            if (t + 1 < NT) mw = mrow[(size_t)(t + 1) << 12];
            if (t <= cw) {
                const LAS unsigned char* kb = lds + KB0 + cur * 8192; const LAS unsigned char* vt = lds + VT0 + cur * VTB;
                f32x16 p0 = nm, p1 = nm;
#pragma unroll
                for (int d0 = 0; d0 < 4; ++d0) {
                    const int sw = ((2 * d0 + hi) ^ ((r32 >> 1) & 7)) << 4;
                    const bf16x8 a0 = *(const LAS bf16x8*)(kb + r32 * 128 + sw), a1 = *(const LAS bf16x8*)(kb + (32 + r32) * 128 + sw);
                    p0 = __builtin_amdgcn_mfma_f32_32x32x16_bf16(a0, qf[d0], p0, 0, 0, 0);
                    p1 = __builtin_amdgcn_mfma_f32_32x32x16_bf16(a1, qf[d0], p1, 0, 0, 0);
                }
                if (64 * t + 63 >= q0 + 32 * wid - 90) {
                    const int base = 64 * t + 4 * hi - myq + 91; const LAS float* bt = BT + h * BT_STRIDE;
#pragma unroll
                    for (int r = 0; r < 16; ++r) { const int cr = (r & 3) + 8 * (r >> 2); int i0 = base + cr, i1 = base + 32 + cr; i0 = i0 < 0 ? 0 : i0; i1 = i1 < 0 ? 0 : i1; p0[r] += bt[i0]; p1[r] += bt[i1]; }
                }
                float mx;
                { float xa = __builtin_fmaxf(__builtin_fmaxf(p0[0], p0[1]), p1[0]), xb = __builtin_fmaxf(__builtin_fmaxf(p0[2], p0[3]), p1[1]); xa = __builtin_fmaxf(__builtin_fmaxf(xa, p1[2]), p1[3]);
#pragma unroll
                  for (int r = 4; r < 16; r += 4) { xa = __builtin_fmaxf(__builtin_fmaxf(xa, p0[r]), p0[r + 1]); xb = __builtin_fmaxf(__builtin_fmaxf(xb, p0[r + 2]), p0[r + 3]); xa = __builtin_fmaxf(__builtin_fmaxf(xa, p1[r]), p1[r + 1]); xb = __builtin_fmaxf(__builtin_fmaxf(xb, p1[r + 2]), p1[r + 3]); }
                  mx = __builtin_fmaxf(xa, xb); }
                mx = __builtin_fmaxf(mx, __shfl_xor(mx, 32));
                if (t == 0 || __any(mx > 4.0f)) {
                    const float dl = (t == 0) ? mx : __builtin_fmaxf(mx, 0.f), al = (t == 0) ? 0.f : __builtin_amdgcn_exp2f(-dl); m += dl; l *= al;
#pragma unroll
                    for (int r = 0; r < 16; ++r) { p0[r] -= dl; p1[r] -= dl; ot0[r] *= al; ot1[r] *= al; nm[r] = -m; }
                }
                float ps = 0.f, ps2 = 0.f;
#pragma unroll
                for (int r = 0; r < 16; ++r) { const int cr = (r & 3) + 8 * (r >> 2);
                    unsigned b0_, b1_; asm("v_bfe_i32 %0, %1, %2, 1" : "=v"(b0_) : "v"(mlo), "i"(cr)); asm("v_bfe_i32 %0, %1, %2, 1" : "=v"(b1_) : "v"(mhi), "i"(cr));
                    const float e0 = __uint_as_float(__float_as_uint(__builtin_amdgcn_exp2f(p0[r])) & b0_);
                    const float e1 = __uint_as_float(__float_as_uint(__builtin_amdgcn_exp2f(p1[r])) & b1_);
                    p0[r] = e0; p1[r] = e1; ps += e0; ps2 += e1; }
                ps += ps2;
                l += ps;
#pragma unroll
                for (int s = 0; s < 4; ++s) {
                    v4u pw;
                    if (s == 0) { pw.x = cvtpk2(p0[0], p0[1]); pw.y = cvtpk2(p0[2], p0[3]); pw.z = cvtpk2(p0[4], p0[5]); pw.w = cvtpk2(p0[6], p0[7]); }
                    else if (s == 1) { pw.x = cvtpk2(p0[8], p0[9]); pw.y = cvtpk2(p0[10], p0[11]); pw.z = cvtpk2(p0[12], p0[13]); pw.w = cvtpk2(p0[14], p0[15]); }
                    else if (s == 2) { pw.x = cvtpk2(p1[0], p1[1]); pw.y = cvtpk2(p1[2], p1[3]); pw.z = cvtpk2(p1[4], p1[5]); pw.w = cvtpk2(p1[6], p1[7]); }
                    else { pw.x = cvtpk2(p1[8], p1[9]); pw.y = cvtpk2(p1[10], p1[11]); pw.z = cvtpk2(p1[12], p1[13]); pw.w = cvtpk2(p1[14], p1[15]); }
                    const bf16x8 pb = __builtin_bit_cast(bf16x8, pw);
                    typedef short v4i16_t __attribute__((ext_vector_type(4)));
                    const LAS unsigned char* vrow = vt + vrd + (16 * s) * VP;
                    const v4i16_t lo0 = __builtin_amdgcn_ds_read_tr16_b64_v4i16((LAS v4i16_t*)(vrow)), hi0 = __builtin_amdgcn_ds_read_tr16_b64_v4i16((LAS v4i16_t*)(vrow + 8 * VP));
                    const v4i16_t lo1 = __builtin_amdgcn_ds_read_tr16_b64_v4i16((LAS v4i16_t*)(vrow + 64)), hi1 = __builtin_amdgcn_ds_read_tr16_b64_v4i16((LAS v4i16_t*)(vrow + 8 * VP + 64));
                    const bf16x8 a0w = {lo0[0], lo0[1], lo0[2], lo0[3], hi0[0], hi0[1], hi0[2], hi0[3]}, a1w = {lo1[0], lo1[1], lo1[2], lo1[3], hi1[0], hi1[1], hi1[2], hi1[3]};
                    ot0 = __builtin_amdgcn_mfma_f32_32x32x16_bf16(a0w, pb, ot0, 0, 0, 0);
                    ot1 = __builtin_amdgcn_mfma_f32_32x32x16_bf16(a1w, pb, ot1, 0, 0, 0);
                }
            }
            __syncthreads();
        }
#undef ATT_WRITE
        const float lt = l + __shfl_xor(l, 32); const float inv = 1.0f / lt;
        u32x2 zw[8];
#pragma unroll
        for (int i = 0; i < 8; ++i) zw[i] = *(const GAS u32x2*)(ZA + tokq * 512 + h * 64 + 32 * (i >> 2) + 8 * (i & 3) + 4 * hi);
        asm volatile("" ::: "memory");
#pragma unroll
        for (int i = 0; i < 8; ++i) {
            const int g = i & 3; const size_t off = tokq * 512 + h * 64 + 32 * (i >> 2) + 8 * g + 4 * hi;
            const float o0 = ((i >> 2) ? ot1[4 * g] : ot0[4 * g]) * inv, o1 = ((i >> 2) ? ot1[4 * g + 1] : ot0[4 * g + 1]) * inv, o2 = ((i >> 2) ? ot1[4 * g + 2] : ot0[4 * g + 2]) * inv, o3 = ((i >> 2) ? ot1[4 * g + 3] : ot0[4 * g + 3]) * inv;
            u32x2 w; w.x = cvtpk2(o0 * pg8::bflo(zw[i].x), o1 * pg8::bfhi(zw[i].x)); w.y = cvtpk2(o2 * pg8::bflo(zw[i].y), o3 * pg8::bfhi(zw[i].y));
            *(GAS u32x2*)(Qb + off) = w;
        }
    }
}

__device__ __forceinline__ void final_phase(const Args& A, int vcu, int G) {
    const int tid = threadIdx.x, lane = tid & 63, wave = __builtin_amdgcn_readfirstlane(tid >> 6);
    const int gw = vcu * NWAVES + wave, NGW = G * NWAVES;
    const float* RS2 = (const float*)(A.ws + WS_RS2);
    f32x4 g[4];
#pragma unroll
    for (int j = 0; j < 4; ++j) g[j] = ((const GAS f32x4*)A.fin_g)[lane + 64 * j];
    const bf16* X2B = (const bf16*)(A.ws + WS_XB);
    for (int m0 = gw * 4; m0 < M; m0 += NGW * 4) {
        u32x2 w[4][4]; float r[4];
#pragma unroll
        for (int q = 0; q < 4; ++q) { r[q] = RS2[m0 + q]; const GAS u32x2* xi = (const GAS u32x2*)(X2B + (size_t)(m0 + q) * DM) + lane;
#pragma unroll
            for (int j = 0; j < 4; ++j) w[q][j] = __builtin_nontemporal_load(xi + 64 * j); }
        asm volatile("" ::: "memory");
#pragma unroll
        for (int q = 0; q < 4; ++q) { const float rs = 1.0f / sqrtf(r[q] * (1.0f / DM) + EPS); GAS f32x4* xo = (GAS f32x4*)(A.out + (size_t)(m0 + q) * DM) + lane;
#pragma unroll
            for (int j = 0; j < 4; ++j) { f32x4 v; v.x = pg8::bflo(w[q][j].x); v.y = pg8::bfhi(w[q][j].x); v.z = pg8::bflo(w[q][j].y); v.w = pg8::bfhi(w[q][j].y); __builtin_nontemporal_store(v * rs * g[j], xo + 64 * j); } }
    }
}
__global__ void __launch_bounds__(NWAVES * 64, 2) mk_fwd(Args args) {
    extern __shared__ __attribute__((aligned(16))) unsigned char lds_raw[];
    LAS unsigned char* lds = (LAS unsigned char*)lds_raw;
    volatile LAS unsigned* MISC = (volatile LAS unsigned*)(lds + MISC_OFF);
    const int tid = threadIdx.x;
    const int G = gridDim.x; int vcu; { const int bx = blockIdx.x; vcu = (G % 8 == 0) ? (bx % 8) * (G / 8) + bx / 8 : bx; }
    unsigned char* ws = args.ws;
    gu32* ctl = (gu32*)(ws + WS_CTL);
    for (int u = tid; u < (LDS_BYTES - LDSCTL_OFF) / 4; u += NWAVES * 64) ((LAS unsigned*)(lds + LDSCTL_OFF))[u] = 0u;
    __syncthreads();
    XcdBarrier bar; bar.bar = (unsigned*)(ctl + CW_BAR); bar.x = 0; bar.st = nullptr;
    if (N_LAUNCHES == 1) bar = xcd_barrier_post((unsigned*)(ctl + CW_BAR), MISC + 8);
#define GRID_BAR() do { if (N_LAUNCHES == 1) xcd_barrier(bar); } while (0)
    const int lo = args.ph_lo, hi = args.ph_hi;
#ifndef MK_PHASE_MASK
#define MK_PHASE_MASK 0xff
#endif
#define IN(k) ((((MK_PHASE_MASK) >> (k)) & 1) && lo <= (k) && (k) < hi)
#define BOTH(k) (IN(k) && IN((k) + 1))
    bf16* XB = (bf16*)(ws + WS_XB);
#ifdef MK_PROBE_A
    unsigned long long* ts = (unsigned long long*)(ws + WS_CTL + 256 * 1024);
#define STAMP(k) do { if (blockIdx.x == 0 && tid == 0) ts[k] = rt(); } while (0)
#else
#define STAMP(k) do { } while (0)
#endif
    STAMP(0);
    if (IN(0)) { p0_prologue(args, lds, vcu, G); if (BOTH(0)) GRID_BAR(); STAMP(1); }
    if (IN(1)) {
        pg8::Gemm g{XB, (const bf16*)(ws + WS_WIN), M, NWP, DM}; pg8::StaticOrder S; S.init(M, NWP, G, (int)blockIdx.x);
        pg8::EpiP1 E{(const float*)(ws + WS_RS0), (bf16*)(ws + WS_Q), (bf16*)(ws + WS_K), (bf16*)(ws + WS_V), (bf16*)(ws + WS_ZA), (bf16*)(ws + WS_QI), (bf16*)(ws + WS_U), (bf16*)(ws + WS_ZB),
                     (bf16*)(ws + WS_GA), (bf16*)(ws + WS_GB), (bf16*)(ws + WS_KI), (float*)(ws + WS_WI)};
        pg8::gemm_phase<pg8::EpiP1, pg8::StaticOrder, PG8_ALIGN, PG8_SP2>(lds, g, S, E);
        if (BOTH(1)) GRID_BAR();
        STAMP(2);
    }
    if (IN(2)) { conv_phase(args, lds, vcu, G); STAMP(9); idx_phase(args, lds, vcu, G); if (BOTH(2)) GRID_BAR(); STAMP(3); }
    if (IN(3)) { attn_phase(args, lds, vcu, G); if (BOTH(3)) GRID_BAR(); STAMP(4); }
    if (IN(4)) {
#ifndef MK_P4_MASK
#define MK_P4_MASK 7
#endif
        if (MK_P4_MASK & 1) {
            static_assert((WS_ZB - WS_Q) % ((size_t)256 * AW * 2) == 0 && (WS_WBB - WS_WBA) % ((size_t)256 * AW * 2) == 0, "second operand pair must sit a whole number of 256-row tiles behind the first");
            constexpr int DPM = (int)((WS_ZB - WS_Q) / ((size_t)256 * AW * 2)), DPN = (int)((WS_WBB - WS_WBA) / ((size_t)256 * AW * 2));
            pg8::Gemm g{(const bf16*)(ws + WS_Q), (const bf16*)(ws + WS_WBA), M, DM, AW}; pg8::PairOrder S; S.so.init(M, DM, G, (int)blockIdx.x); S.dpm = DPM; S.dpn = DPN;
            pg8::EpiBranch E{(const bf16*)(ws + WS_GA), (const bf16*)(ws + WS_GB), (bf16*)(ws + WS_K), DM, DPM, DPN};
            pg8::gemm_phase<pg8::EpiBranch, pg8::PairOrder, PG8_ALIGN, PG8_SP2>(lds, g, S, E); }
        if (MK_P4_MASK & 4) { int kple = PLE; asm volatile("" : "+s"(kple));
          pg8::Gemm g{(const bf16*)(ws + WS_PB), (const bf16*)(ws + WS_WPP), M, DM, kple}; pg8::StaticOrder S; S.init(M, DM, G, (int)blockIdx.x);
          pg8::EpiPlain E{(bf16*)(ws + WS_GB), DM};
          pg8::gemm_phase<pg8::EpiPlain, pg8::StaticOrder, PG8_ALIGN, PG8_SP2>(lds, g, S, E); }
        if (BOTH(4)) GRID_BAR();
        STAMP(5);
    }
    if (IN(5)) {
        pg8::Gemm g{(const bf16*)(ws + WS_K), (const bf16*)(ws + WS_WOUT), M, DM, DM}; pg8::StaticOrder S; S.init(M, DM, G, (int)blockIdx.x);
        pg8::EpiX1 E{XB, (bf16*)(ws + WS_GA), (float*)(ws + WS_RS1), DM};
        pg8::gemm_phase<pg8::EpiX1, pg8::StaticOrder, PG8_ALIGN, PG8_SP2>(lds, g, S, E);
        if (BOTH(5)) GRID_BAR();
        STAMP(6);
    }
    if (IN(6)) {
        pg8::Gemm g{(const bf16*)(ws + WS_GA), (const bf16*)(ws + WS_WPG), M, DM, DM}; pg8::StaticOrder S; S.init(M, DM, G, (int)blockIdx.x);
        pg8::EpiX2 E{(const bf16*)(ws + WS_GA), (const bf16*)(ws + WS_GB), XB, (const float*)(ws + WS_RS1), (float*)(ws + WS_RS2), DM, EPS};
        pg8::gemm_phase<pg8::EpiX2, pg8::StaticOrder, PG8_ALIGN, PG8_SP2>(lds, g, S, E);
        if (BOTH(6)) GRID_BAR();
        STAMP(7);
    }
    if (IN(7)) final_phase(args, vcu, G);
#ifdef MK_PROBE_A
    if (blockIdx.x == 0 && tid == 0) { const unsigned long long t8 = rt(); const unsigned long long dt = ts[MK_PROBE_HI] - ts[MK_PROBE_LO]; while (rt() < t8 + (unsigned long long)MK_PROBE_MULT * dt) __builtin_amdgcn_s_sleep(32); }
#endif
#undef IN
#undef BOTH
#undef GRID_BAR
}

extern "C" void kernel_launch(void* const* d_in, const int* in_sizes, int n_in, void* d_out, int out_size, void* d_ws, size_t ws_size, hipStream_t stream) {
    static int grid = 0;
    if (grid == 0) {
        if (n_in != 16 || out_size != M * DM || ws_size < WS_END) { fprintf(stderr, "kernel_launch: unexpected problem (n_in %d, out %d, ws %zu); nothing launched\n", n_in, out_size, ws_size); grid = -1; return; }
        int dev = 0, cus = 0, per_cu = 0;
        if (hipGetDevice(&dev) != hipSuccess || hipDeviceGetAttribute(&cus, hipDeviceAttributeMultiprocessorCount, dev) != hipSuccess) { grid = -1; return; }
        if (hipFuncSetAttribute((const void*)mk_fwd, hipFuncAttributeMaxDynamicSharedMemorySize, LDS_BYTES) != hipSuccess) { fprintf(stderr, "kernel_launch: hipFuncSetAttribute failed\n"); grid = -1; return; }
        if (hipOccupancyMaxActiveBlocksPerMultiprocessor(&per_cu, (const void*)mk_fwd, NWAVES * 64, LDS_BYTES) != hipSuccess || per_cu < 1) { fprintf(stderr, "kernel_launch: occupancy query says %d blocks per CU\n", per_cu); per_cu = 1; }
        (void)hipGetLastError();
        grid = cus;
    }
    if (grid < 0) return;
    if (hipMemsetAsync((char*)d_ws + WS_CTL, 0, CTL_ZERO_BYTES, stream) != hipSuccess) { fprintf(stderr, "kernel_launch: memset failed\n"); return; }
    Args a{};
    a.x = (const float*)d_in[0]; a.p = (const float*)d_in[1]; a.norm_in_g = (const float*)d_in[2]; a.w_in = (const float*)d_in[3]; a.conv_w = (const float*)d_in[4]; a.conv_b = (const float*)d_in[5];
    a.conv_ln_g = (const float*)d_in[6]; a.conv_ln_b = (const float*)d_in[7]; a.w_ba = (const float*)d_in[8]; a.w_bb = (const float*)d_in[9]; a.w_out = (const float*)d_in[10]; a.ple_g = (const float*)d_in[11];
    a.w_pg = (const float*)d_in[12]; a.w_pp = (const float*)d_in[13]; a.rel_bias = (const float*)d_in[14]; a.fin_g = (const float*)d_in[15];
    a.out = (float*)d_out; a.ws = (unsigned char*)d_ws;
    for (int li = 0; li < N_LAUNCHES; ++li) {
        if (N_LAUNCHES == 1) { a.ph_lo = 0; a.ph_hi = N_PHASES; } else { a.ph_lo = li; a.ph_hi = li + 1; }
        if (N_LAUNCHES == 1) {
            void* kargs[] = {&a};
            hipError_t e = hipLaunchCooperativeKernel((const void*)mk_fwd, dim3(grid), dim3(NWAVES * 64), kargs, LDS_BYTES, stream);
            if (e != hipSuccess) { (void)hipGetLastError(); fprintf(stderr, "kernel_launch: cooperative launch failed (%s); plain launch instead\n", hipGetErrorName(e)); hipLaunchKernelGGL(mk_fwd, dim3(grid), dim3(NWAVES * 64), LDS_BYTES, stream, a); }
        } else {
            hipLaunchKernelGGL(mk_fwd, dim3(grid), dim3(NWAVES * 64), LDS_BYTES, stream, a);
        }
        const hipError_t le = hipPeekAtLastError();
        if (le != hipSuccess) { fprintf(stderr, "kernel_launch: launch %d failed: %s\n", li, hipGetErrorName(le)); break; }
    }
}
```

```cpp
#include <hip/hip_runtime.h>
#include <cstdio>
#include <cstdint>
#define MK_N_LAUNCHES 1
namespace pg8 {
#define PG8_LAS __attribute__((address_space(3)))
typedef unsigned short bf16_t;
typedef short bf16x8 __attribute__((ext_vector_type(8)));
typedef float f32x4 __attribute__((ext_vector_type(4)));
typedef unsigned u32x4 __attribute__((ext_vector_type(4)));
constexpr int BM = 256, BK = 64, HALF = 128, HTB = HALF * BK * 2  , STAGE_BYTES = 8 * HTB, NXCD = 8, WGM = 8;

__host__ __device__ __forceinline__ int lds_byte(int r, int c) { const int st = (r >> 4) * 2 + (c >> 5), rr = r & 15, cc = c & 31, ob = rr * 64 + cc * 2; return st * 1024 + (ob ^ (((ob >> 9) & 1) << 5)); }
__host__ __device__ __forceinline__ void stage_rc(int b, int& R, int& C) { const int st = b / 1024, sb = b % 1024, swz = sb ^ (((sb >> 9) & 1) << 5); R = (st >> 1) * 16 + swz / 64; C = (st & 1) * 32 + (swz % 64) / 2; }
__host__ __device__ __forceinline__ int perm32(int rho) { const int n = rho >> 4, i = rho & 15; return 8 * (i >> 2) + 4 * n + (i & 3); }

struct Unit { int pm, pn; };
struct Gemm { const bf16_t* A; const bf16_t* Bt; int M, N, K; };

struct StaticOrder {
    int nM, nN, nwg, G, c;
    __host__ __device__ void init(int M, int N, int G_, int c_) { nM = M / BM; nN = N / BM; nwg = nM * nN; G = G_; c = c_; }
    __host__ __device__ bool next(int i, Unit& u) const {
        const long L = (long)i * G + c; if (L >= nwg) return false;
        int wgid = (int)L; { const int q = nwg / NXCD, r = nwg % NXCD, xcd = wgid % NXCD, off = wgid / NXCD; wgid = (xcd < r ? xcd * (q + 1) : r * (q + 1) + (xcd - r) * q) + off; }
        const int nig = WGM * nN, gid = wgid / nig, fm = gid * WGM, gsz = (nM - fm) < WGM ? (nM - fm) : WGM;
        u.pm = fm + ((wgid % nig) % gsz); u.pn = (wgid % nig) / gsz; return true;
    }
    __device__ __forceinline__ void a_ready(const Unit&) const {}
    __device__ __forceinline__ void done(const Unit&) const {}
};

__device__ __forceinline__ unsigned cvt_pk_bf16(float lo, float hi) { unsigned r; asm volatile("v_cvt_pk_bf16_f32 %0, %1, %2" : "=v"(r) : "v"(lo), "v"(hi)); return r; }
typedef float f32x2 __attribute__((ext_vector_type(2)));
template <class Epi, class Sched, bool ALIGN_EPI = false, bool SP2 = false>
__device__ __forceinline__ void gemm_phase(PG8_LAS unsigned char* lds, const Gemm g, const Sched& S, const Epi& E) {
    const int tid = threadIdx.x, wid = __builtin_amdgcn_readfirstlane(tid >> 6), lane = tid & 63, wr = wid >> 2, wc = wid & 3, fr = lane & 15, fq = lane >> 4;
    const int K = g.K, nt = K / BK;
    unsigned voffA[2], voffB[2];
#pragma unroll
    for (int i = 0; i < 2; ++i) { int R, C; stage_rc(tid * 16 + i * 8192, R, C); const int Rb = Epi::PERM ? ((R & ~31) + perm32(R & 31)) : R;
        voffA[i] = (unsigned)(R * K + C) * 2u; voffB[i] = (unsigned)(Rb * K + C) * 2u; }
    const size_t kstep = (size_t)(BK * 2);
    const size_t hstep = (size_t)HALF * K * 2;
    const size_t tstep = 2 * hstep;
    const unsigned ldsw = (unsigned)wid * 1024u;
    const int aoff = lds_byte(wr * 64 + fr, fq * 8), boff = lds_byte(wc * 32 + fr, fq * 8);
#define PG8_SA(b, h) (((b) * 2 + (h)) * HTB)
#define PG8_SB(b, h) ((4 + (b) * 2 + (h)) * HTB)
#define PG8_STAGE(bufoff, gbase, voff) do { _Pragma("unroll") for (int _i = 0; _i < 2; ++_i) \
        __builtin_amdgcn_global_load_lds((const unsigned*)((const char*)(gbase) + (voff)[_i]), (PG8_LAS unsigned*)(lds + (bufoff) + ldsw + _i * 8192), 16, 0, 0); } while (0)
#define PG8_LDA(dst, b, h) do { _Pragma("unroll") for (int m = 0; m < 4; ++m) _Pragma("unroll") for (int k = 0; k < 2; ++k) dst[m][k] = *(const PG8_LAS bf16x8*)(lds + PG8_SA(b, h) + aoff + m * 2048 + k * 1024); } while (0)
#define PG8_LDB(dst, b, h) do { _Pragma("unroll") for (int n = 0; n < 2; ++n) _Pragma("unroll") for (int k = 0; k < 2; ++k) dst[n][k] = *(const PG8_LAS bf16x8*)(lds + PG8_SB(b, h) + boff + n * 2048 + k * 1024); } while (0)
#define PG8_MMA(ai, bj, At, Bt) do { __builtin_amdgcn_s_setprio(1); _Pragma("unroll") for (int m = 0; m < 4; ++m) _Pragma("unroll") for (int n = 0; n < 2; ++n) _Pragma("unroll") for (int k = 0; k < 2; ++k) \
        acc[ai][bj][m][n] = __builtin_amdgcn_mfma_f32_16x16x32_bf16(Bt[n][k], At[m][k], acc[ai][bj][m][n], 0, 0, 0); __builtin_amdgcn_s_setprio(0); } while (0)
#define PG8_WAIT_V(n) asm volatile("s_waitcnt vmcnt(" #n ")" ::: "memory")
#define PG8_WAIT_L(n) asm volatile("s_waitcnt lgkmcnt(" #n ")" ::: "memory")
#define PG8_BAR __builtin_amdgcn_s_barrier()
#define PG8_SCHED __builtin_amdgcn_sched_barrier(0)
    Unit cur, nxt; int ui = 0;
    if (!S.next(0, cur)) return;
    f32x4 acc[2][2][4][2];
#pragma unroll
    for (int a = 0; a < 2; ++a)
#pragma unroll
        for (int b = 0; b < 2; ++b)
#pragma unroll
            for (int m = 0; m < 4; ++m)
#pragma unroll
                for (int n = 0; n < 2; ++n) acc[a][b][m][n] = (f32x4){0.f, 0.f, 0.f, 0.f};
    bf16x8 At[4][2], B0[2][2], B1[2][2];
    const char* cA = (const char*)g.A + (size_t)cur.pm * tstep; const char* cB = (const char*)g.Bt + (size_t)cur.pn * tstep;
    S.a_ready(cur);
    if constexpr (SP2) {
        PG8_STAGE(PG8_SB(0, 0), cB, voffB); PG8_STAGE(PG8_SB(0, 1), cB + hstep, voffB); PG8_STAGE(PG8_SA(0, 0), cA, voffA); PG8_STAGE(PG8_SA(0, 1), cA + hstep, voffA);
        if (wr == 1) PG8_BAR;
        PG8_WAIT_V(2); PG8_BAR;
        PG8_STAGE(PG8_SB(1, 0), cB + kstep, voffB); PG8_STAGE(PG8_SA(1, 0), cA + kstep, voffA); PG8_STAGE(PG8_SB(1, 1), cB + hstep + kstep, voffB);
        PG8_WAIT_V(6); PG8_BAR;
    } else {
        PG8_STAGE(PG8_SB(0, 0), cB, voffB); PG8_STAGE(PG8_SA(0, 0), cA, voffA); PG8_STAGE(PG8_SB(0, 1), cB + hstep, voffB); PG8_STAGE(PG8_SA(0, 1), cA + hstep, voffA);
        if (wr == 1) PG8_BAR;
        PG8_WAIT_V(4); PG8_BAR;
        PG8_STAGE(PG8_SB(1, 0), cB + kstep, voffB); PG8_STAGE(PG8_SA(1, 0), cA + kstep, voffA); PG8_STAGE(PG8_SB(1, 1), cB + hstep + kstep, voffB);
        PG8_WAIT_V(6); PG8_BAR;
    }
    for (;;) {
        const bool has_next = S.next(ui + 1, nxt);
        const char* nA = has_next ? (const char*)g.A + (size_t)nxt.pm * tstep : cA; const char* nB = has_next ? (const char*)g.Bt + (size_t)nxt.pn * tstep : cB;
        for (int t = 0; t < nt; t += 2) {
            const bool last = (t == nt - 2);
            const char* a1 = cA + (size_t)(t + 1) * kstep;
            const char* a2 = last ? nA : cA + (size_t)(t + 2) * kstep; const char* b2 = last ? nB : cB + (size_t)(t + 2) * kstep;
            const char* a3 = a2 + kstep; const char* b3 = b2 + kstep;
            if (last && has_next) S.a_ready(nxt);
            if constexpr (SP2) {
            PG8_LDB(B0, 0, 0); PG8_LDB(B1, 0, 1); PG8_SCHED; PG8_LDA(At, 0, 0); PG8_STAGE(PG8_SA(1, 1), a1 + hstep, voffA);
            PG8_WAIT_V(8); PG8_WAIT_L(0); PG8_BAR; PG8_MMA(0, 0, At, B0); PG8_MMA(0, 1, At, B1); PG8_BAR; PG8_SCHED;
            PG8_LDA(At, 0, 1); PG8_STAGE(PG8_SB(0, 0), b2, voffB); PG8_STAGE(PG8_SB(0, 1), b2 + hstep, voffB); PG8_STAGE(PG8_SA(0, 0), a2, voffA);
            PG8_WAIT_V(8); PG8_WAIT_L(0); PG8_BAR; PG8_MMA(1, 0, At, B0); PG8_MMA(1, 1, At, B1); PG8_BAR; PG8_SCHED;
            PG8_LDB(B0, 1, 0); PG8_LDB(B1, 1, 1); PG8_SCHED; PG8_LDA(At, 1, 0); PG8_STAGE(PG8_SA(0, 1), a2 + hstep, voffA);
            PG8_WAIT_V(8); PG8_WAIT_L(0); PG8_BAR; PG8_MMA(0, 0, At, B0); PG8_MMA(0, 1, At, B1); PG8_BAR; PG8_SCHED;
            PG8_LDA(At, 1, 1); PG8_STAGE(PG8_SB(1, 0), b3, voffB); PG8_STAGE(PG8_SB(1, 1), b3 + hstep, voffB); PG8_STAGE(PG8_SA(1, 0), a3, voffA);
            PG8_WAIT_V(8); PG8_WAIT_L(0); PG8_BAR; PG8_MMA(1, 0, At, B0); PG8_MMA(1, 1, At, B1); PG8_BAR; PG8_SCHED;
            } else {
            PG8_LDB(B0, 0, 0); PG8_SCHED; PG8_LDA(At, 0, 0); PG8_STAGE(PG8_SA(1, 1), a1 + hstep, voffA);
            PG8_WAIT_L(8); PG8_BAR; PG8_WAIT_L(0); PG8_MMA(0, 0, At, B0); PG8_BAR; PG8_SCHED;
            PG8_LDB(B1, 0, 1); PG8_STAGE(PG8_SB(0, 0), b2, voffB);
            PG8_BAR; PG8_WAIT_L(0); PG8_MMA(0, 1, At, B1); PG8_BAR;
            PG8_LDA(At, 0, 1); PG8_STAGE(PG8_SA(0, 0), a2, voffA);
            PG8_BAR; PG8_WAIT_L(0); PG8_MMA(1, 0, At, B0); PG8_BAR; PG8_SCHED;
            PG8_STAGE(PG8_SB(0, 1), b2 + hstep, voffB);
            PG8_WAIT_V(6); PG8_BAR; PG8_MMA(1, 1, At, B1); PG8_BAR;
            PG8_LDB(B0, 1, 0); PG8_SCHED; PG8_LDA(At, 1, 0); PG8_STAGE(PG8_SA(0, 1), a2 + hstep, voffA);
            PG8_WAIT_L(8); PG8_BAR; PG8_WAIT_L(0); PG8_MMA(0, 0, At, B0); PG8_BAR; PG8_SCHED;
            PG8_LDB(B1, 1, 1); PG8_STAGE(PG8_SB(1, 0), b3, voffB);
            PG8_BAR; PG8_WAIT_L(0); PG8_MMA(0, 1, At, B1); PG8_BAR;
            PG8_LDA(At, 1, 1); PG8_STAGE(PG8_SA(1, 0), a3, voffA);
            PG8_BAR; PG8_WAIT_L(0); PG8_MMA(1, 0, At, B0); PG8_BAR; PG8_SCHED;
            PG8_STAGE(PG8_SB(1, 1), b3 + hstep, voffB);
            PG8_WAIT_V(6); PG8_BAR; PG8_MMA(1, 1, At, B1); PG8_BAR;
            }
        }
        if constexpr (ALIGN_EPI) { if (wr == 0) PG8_BAR; }
        if constexpr (!Epi::AFTER_DRAIN) { E(acc, cur, wr, wc, fr, fq); S.done(cur); }
        if (!has_next) break;
        if (!E.keep(cur)) {
#pragma unroll
        for (int a = 0; a < 2; ++a)
#pragma unroll
            for (int b = 0; b < 2; ++b)
#pragma unroll
                for (int m = 0; m < 4; ++m)
#pragma unroll
                    for (int n = 0; n < 2; ++n) acc[a][b][m][n] = (f32x4){0.f, 0.f, 0.f, 0.f};
        }
        cur = nxt; cA = nA; cB = nB; ++ui;
        if constexpr (ALIGN_EPI) { if (wr == 1) PG8_BAR; }
    }
    PG8_WAIT_V(0);
    if constexpr (!ALIGN_EPI) { if (wr == 0) PG8_BAR; }
    PG8_BAR;
    if constexpr (Epi::AFTER_DRAIN) { E.fused(acc, cur, wr, wc, fr, fq, lds, wid, lane); S.done(cur); }
#undef PG8_SA
#undef PG8_SB
#undef PG8_STAGE
#undef PG8_LDA
#undef PG8_LDB
#undef PG8_MMA
#undef PG8_WAIT_V
#undef PG8_WAIT_L
#undef PG8_BAR
#undef PG8_SCHED
}
}

#ifndef PG8_SP2
#define PG8_SP2 true
#endif
#ifndef PG8_ALIGN
#define PG8_ALIGN true
#endif
namespace pg8 {
typedef unsigned u32x2 __attribute__((ext_vector_type(2)));
__device__ __forceinline__ unsigned cvtpk(float lo, float hi) { typedef float f2_ __attribute__((ext_vector_type(2))); typedef __bf16 b2_ __attribute__((ext_vector_type(2))); f2_ v = {lo, hi}; b2_ b = __builtin_convertvector(v, b2_); return __builtin_bit_cast(unsigned, b); }
__device__ __forceinline__ float bflo(unsigned u) { return __uint_as_float(u << 16); }
__device__ __forceinline__ float bfhi(unsigned u) { return __uint_as_float(u & 0xffff0000u); }
__device__ __forceinline__ float sigm_f(float x) { return __builtin_amdgcn_rcpf(1.0f + __builtin_amdgcn_exp2f(-1.4426950408889634f * x)); }
constexpr float Q_SCALE = 0.125f * 1.4426950408889634f;
constexpr float IDX_SCALE = 0.125f * 0.35355339059327373f;

__device__ __forceinline__ void prefetch_tile_bf16(const bf16_t* base, int ldc, int row0, int col0, PG8_LAS unsigned char* lds, int tid) {
    PG8_LAS unsigned* scrap = (PG8_LAS unsigned*)(lds + 135168 + (tid >> 6) * 256);
#pragma unroll
    for (int j = 0; j < 2; ++j) { const int li = tid + 512 * j; const bf16_t* p = base + (size_t)(row0 + (li >> 2)) * ldc + col0 + (li & 3) * 64;
        __builtin_amdgcn_global_load_lds((const unsigned*)p, scrap, 4, 0, 0); }
}
struct EpiP1 {
    static constexpr bool PERM = true, AFTER_DRAIN = false;
    __device__ __forceinline__ bool keep(const Unit&) const { return false; }
    __device__ __forceinline__ void prefetch(const Unit&, PG8_LAS unsigned char*, int) const {}
    const float* rs0; bf16_t *Q, *Kb, *V, *ZA, *QI, *U, *ZB, *GA, *GB, *KI; float* WI;
    __device__ __forceinline__ void operator()(const f32x4 (&acc)[2][2][4][2], const Unit& u, int wr, int wc, int fr, int fq) const {
        const int pn = u.pn; const int row0 = u.pm * BM + wr * 64 + fr;
        int type = 0; bf16_t* base = Q; int ld = 512, colt = 0; float sc = 1.f;
        if (pn < 10) { const int sec = pn >> 1; base = sec == 0 ? Q : sec == 1 ? Kb : sec == 2 ? V : sec == 3 ? ZA : QI; colt = (pn & 1) * 256; type = (sec == 3) ? 1 : 0; if (sec == 0) sc = Q_SCALE; }
        else if (pn < 14) { type = 3; base = U; colt = (pn - 10) * 128; }
        else if (pn < 16) { type = 1; base = ZB; colt = (pn - 14) * 256; }
        else if (pn < 20) { type = 2; base = GA; ld = 1024; colt = (pn - 16) * 256; }
        else if (pn < 24) { type = 2; base = GB; ld = 1024; colt = (pn - 20) * 256; }
        else type = 4;
        const int col0 = colt + wc * 32 + 8 * fq;
        float rsv[2][4];
#pragma unroll
        for (int ai = 0; ai < 2; ++ai)
#pragma unroll
            for (int m = 0; m < 4; ++m) rsv[ai][m] = rs0[row0 + ai * HALF + m * 16];
        asm volatile("" ::: "memory");
#pragma unroll
        for (int ai = 0; ai < 2; ++ai)
#pragma unroll
            for (int m = 0; m < 4; ++m) {
                const int row = row0 + ai * HALF + m * 16;
                const float r = rsv[ai][m] * sc;
                if (type <= 2) {
                    bf16_t* rowp = base + (size_t)row * ld + col0;
#pragma unroll
                    for (int bj = 0; bj < 2; ++bj) {
                        f32x4 v0 = acc[ai][bj][m][0] * r, v1 = acc[ai][bj][m][1] * r;
                        if (type == 1) {
#pragma unroll
                            for (int e = 0; e < 4; ++e) { v0[e] = v0[e] * sigm_f(v0[e]); v1[e] = v1[e] * sigm_f(v1[e]); }
                        } else if (type == 2) {
#pragma unroll
                            for (int e = 0; e < 4; ++e) { v0[e] = sigm_f(v0[e]); v1[e] = sigm_f(v1[e]); }
                        }
                        u32x4 w; w.x = cvtpk(v0[0], v0[1]); w.y = cvtpk(v0[2], v0[3]); w.z = cvtpk(v1[0], v1[1]); w.w = cvtpk(v1[2], v1[3]);
                        if (type == 2) __builtin_nontemporal_store(w, (u32x4*)(rowp + bj * HALF));
                        else *(u32x4*)(rowp + bj * HALF) = w;
                    }
                } else if (type == 3) {
                    f32x4 a0 = acc[ai][0][m][0] * r, a1 = acc[ai][0][m][1] * r, b0 = acc[ai][1][m][0] * r, b1 = acc[ai][1][m][1] * r;
#pragma unroll
                    for (int e = 0; e < 4; ++e) { a0[e] = a0[e] * sigm_f(b0[e]); a1[e] = a1[e] * sigm_f(b1[e]); }
                    u32x4 w; w.x = cvtpk(a0[0], a0[1]); w.y = cvtpk(a0[2], a0[3]); w.z = cvtpk(a1[0], a1[1]); w.w = cvtpk(a1[2], a1[3]);
                    *(u32x4*)(base + (size_t)row * 512 + col0) = w;
                } else {
                    if (wc < 2) {
                        const f32x4 v0 = acc[ai][0][m][0] * r, v1 = acc[ai][0][m][1] * r;
                        u32x4 w; w.x = cvtpk(v0[0], v0[1]); w.y = cvtpk(v0[2], v0[3]); w.z = cvtpk(v1[0], v1[1]); w.w = cvtpk(v1[2], v1[3]);
                        const int c0 = wc * 32 + 8 * fq;
                        *(u32x4*)(KI + (size_t)(row >> 5) * 2048 + (((c0 >> 4) * 2 + ((c0 >> 3) & 1)) * 32 + (row & 31)) * 8) = w;
                    } else if (wc == 2 && fq == 0) {
                        const float rr = r * IDX_SCALE;
                        *(f32x4*)(WI + (size_t)row * 8) = acc[ai][0][m][0] * rr;
                        *(f32x4*)(WI + (size_t)row * 8 + 4) = acc[ai][0][m][1] * rr;
                    }
                }
            }
    }
};

template <bool ADD> struct EpiGate {
    static constexpr bool PERM = true, AFTER_DRAIN = false;
    __device__ __forceinline__ bool keep(const Unit&) const { return false; }
    __device__ __forceinline__ void prefetch(const Unit&, PG8_LAS unsigned char*, int) const {}
    const bf16_t* G; bf16_t* O; int ldc;
    __device__ __forceinline__ void operator()(const f32x4 (&acc)[2][2][4][2], const Unit& u, int wr, int wc, int fr, int fq) const {
        const int row0 = u.pm * BM + wr * 64 + fr, col0 = u.pn * BM + wc * 32 + 8 * fq;
#pragma unroll
        for (int ai = 0; ai < 2; ++ai) {
            u32x4 gv[4][2], ov[4][2];
#pragma unroll
            for (int m = 0; m < 4; ++m)
#pragma unroll
                for (int bj = 0; bj < 2; ++bj) { const size_t off = (size_t)(row0 + ai * HALF + m * 16) * ldc + col0 + bj * HALF; gv[m][bj] = *(const u32x4*)(G + off); if (ADD) ov[m][bj] = *(const u32x4*)(O + off); }
            asm volatile("" ::: "memory");
#pragma unroll
            for (int m = 0; m < 4; ++m)
#pragma unroll
                for (int bj = 0; bj < 2; ++bj) {
                    const size_t off = (size_t)(row0 + ai * HALF + m * 16) * ldc + col0 + bj * HALF; const u32x4 g = gv[m][bj];
                    f32x4 v0 = acc[ai][bj][m][0], v1 = acc[ai][bj][m][1];
                    v0[0] *= bflo(g.x); v0[1] *= bfhi(g.x); v0[2] *= bflo(g.y); v0[3] *= bfhi(g.y); v1[0] *= bflo(g.z); v1[1] *= bfhi(g.z); v1[2] *= bflo(g.w); v1[3] *= bfhi(g.w);
                    if (ADD) { const u32x4 o = ov[m][bj];
                        v0[0] += bflo(o.x); v0[1] += bfhi(o.x); v0[2] += bflo(o.y); v0[3] += bfhi(o.y); v1[0] += bflo(o.z); v1[1] += bfhi(o.z); v1[2] += bflo(o.w); v1[3] += bfhi(o.w); }
                    u32x4 w; w.x = cvtpk(v0[0], v0[1]); w.y = cvtpk(v0[2], v0[3]); w.z = cvtpk(v1[0], v1[1]); w.w = cvtpk(v1[2], v1[3]);
                    *(u32x4*)(O + off) = w;
                }
            asm volatile("" ::: "memory");
        }
    }
};

struct PairOrder {
    StaticOrder so; int dpm, dpn;
    __device__ bool next(int i, Unit& u) const { Unit b; if (!so.next(i >> 1, b)) return false; u.pm = b.pm + ((i & 1) ? dpm : 0); u.pn = b.pn + ((i & 1) ? dpn : 0); return true; }
    __device__ __forceinline__ void a_ready(const Unit&) const {}
    __device__ __forceinline__ void done(const Unit&) const {}
};
struct EpiBranch {
    static constexpr bool PERM = true, AFTER_DRAIN = false;
    const bf16_t* GA; const bf16_t* GB; bf16_t* O; int ldc, dpm, dpn;
    __device__ __forceinline__ bool keep(const Unit& u) const { return u.pm < dpm; }
    __device__ __forceinline__ void prefetch(const Unit& u, PG8_LAS unsigned char* lds, int tid) const { if (u.pm < dpm) { prefetch_tile_bf16(GA, ldc, u.pm * BM, u.pn * BM, lds, tid); prefetch_tile_bf16(GB, ldc, u.pm * BM, u.pn * BM, lds, tid); } }
    __device__ __forceinline__ void operator()(f32x4 (&acc)[2][2][4][2], const Unit& u, int wr, int wc, int fr, int fq) const {
        const bool second = u.pm >= dpm; const int pm = second ? u.pm - dpm : u.pm, pn = second ? u.pn - dpn : u.pn;
        const int row0 = pm * BM + wr * 64 + fr, col0 = pn * BM + wc * 32 + 8 * fq;
#pragma unroll
        for (int ai = 0; ai < 2; ++ai) {
            u32x4 gb[4][2], ga[4][2];
#pragma unroll
            for (int m = 0; m < 4; ++m)
#pragma unroll
                for (int bj = 0; bj < 2; ++bj) { const size_t off = (size_t)(row0 + ai * HALF + m * 16) * ldc + col0 + bj * HALF; gb[m][bj] = second ? __builtin_nontemporal_load((const u32x4*)(GB + off)) : *(const u32x4*)(GB + off); if (!second) ga[m][bj] = __builtin_nontemporal_load((const u32x4*)(GA + off)); }
            asm volatile("" ::: "memory");
#pragma unroll
            for (int m = 0; m < 4; ++m)
#pragma unroll
                for (int bj = 0; bj < 2; ++bj) {
                    const u32x4 b = gb[m][bj];
                    if (!second) {
                        const u32x4 a = ga[m][bj];
                        acc[ai][bj][m][0][0] *= bflo(a.x) * __builtin_amdgcn_rcpf(bflo(b.x)); acc[ai][bj][m][0][1] *= bfhi(a.x) * __builtin_amdgcn_rcpf(bfhi(b.x));
                        acc[ai][bj][m][0][2] *= bflo(a.y) * __builtin_amdgcn_rcpf(bflo(b.y)); acc[ai][bj][m][0][3] *= bfhi(a.y) * __builtin_amdgcn_rcpf(bfhi(b.y));
                        acc[ai][bj][m][1][0] *= bflo(a.z) * __builtin_amdgcn_rcpf(bflo(b.z)); acc[ai][bj][m][1][1] *= bfhi(a.z) * __builtin_amdgcn_rcpf(bfhi(b.z));
                        acc[ai][bj][m][1][2] *= bflo(a.w) * __builtin_amdgcn_rcpf(bflo(b.w)); acc[ai][bj][m][1][3] *= bfhi(a.w) * __builtin_amdgcn_rcpf(bfhi(b.w));
                    } else {
                        const f32x4 v0 = acc[ai][bj][m][0], v1 = acc[ai][bj][m][1];
                        u32x4 w; w.x = cvtpk(v0[0] * bflo(b.x), v0[1] * bfhi(b.x)); w.y = cvtpk(v0[2] * bflo(b.y), v0[3] * bfhi(b.y)); w.z = cvtpk(v1[0] * bflo(b.z), v1[1] * bfhi(b.z)); w.w = cvtpk(v1[2] * bflo(b.w), v1[3] * bfhi(b.w));
                        *(u32x4*)(O + (size_t)(row0 + ai * HALF + m * 16) * ldc + col0 + bj * HALF) = w;
                    }
                }
            asm volatile("" ::: "memory");
        }
    }
};

struct EpiPlain {
    static constexpr bool PERM = true, AFTER_DRAIN = false;
    __device__ __forceinline__ bool keep(const Unit&) const { return false; }
    __device__ __forceinline__ void prefetch(const Unit&, PG8_LAS unsigned char*, int) const {}
    bf16_t* O; int ldc;
    __device__ __forceinline__ void operator()(const f32x4 (&acc)[2][2][4][2], const Unit& u, int wr, int wc, int fr, int fq) const {
        const int row0 = u.pm * BM + wr * 64 + fr, col0 = u.pn * BM + wc * 32 + 8 * fq;
#pragma unroll
        for (int ai = 0; ai < 2; ++ai)
#pragma unroll
            for (int m = 0; m < 4; ++m) {
                bf16_t* rowp = O + (size_t)(row0 + ai * HALF + m * 16) * ldc + col0;
#pragma unroll
                for (int bj = 0; bj < 2; ++bj) {
                    const f32x4 v0 = acc[ai][bj][m][0], v1 = acc[ai][bj][m][1];
                    u32x4 w; w.x = cvtpk(v0[0], v0[1]); w.y = cvtpk(v0[2], v0[3]); w.z = cvtpk(v1[0], v1[1]); w.w = cvtpk(v1[2], v1[3]);
                    *(u32x4*)(rowp + bj * HALF) = w;
                }
            }
    }
};

struct EpiX1 {
    static constexpr bool PERM = true, AFTER_DRAIN = false;
    __device__ __forceinline__ bool keep(const Unit&) const { return false; }
    __device__ __forceinline__ void prefetch(const Unit& u, PG8_LAS unsigned char* lds, int tid) const { prefetch_tile_bf16(xin, ldc, u.pm * BM, u.pn * BM, lds, tid); }
    const bf16_t* xin; bf16_t* x1b; float* rss; int ldc;
    __device__ __forceinline__ void operator()(const f32x4 (&acc)[2][2][4][2], const Unit& u, int wr, int wc, int fr, int fq) const {
        const int row0 = u.pm * BM + wr * 64 + fr, col0 = u.pn * BM + wc * 32 + 8 * fq;
#pragma unroll
        for (int ai = 0; ai < 2; ++ai) {
            u32x4 xv[4][2];
#pragma unroll
            for (int m = 0; m < 4; ++m)
#pragma unroll
                for (int bj = 0; bj < 2; ++bj) xv[m][bj] = *(const u32x4*)(xin + (size_t)(row0 + ai * HALF + m * 16) * ldc + col0 + bj * HALF);
            asm volatile("" ::: "memory");
#pragma unroll
            for (int m = 0; m < 4; ++m) {
                const int row = row0 + ai * HALF + m * 16; const size_t off = (size_t)row * ldc + col0; float s = 0.f;
#pragma unroll
                for (int bj = 0; bj < 2; ++bj) {
                    const u32x4 xi = xv[m][bj];
                    f32x4 v0 = acc[ai][bj][m][0], v1 = acc[ai][bj][m][1];
                    v0[0] += bflo(xi.x); v0[1] += bfhi(xi.x); v0[2] += bflo(xi.y); v0[3] += bfhi(xi.y); v1[0] += bflo(xi.z); v1[1] += bfhi(xi.z); v1[2] += bflo(xi.w); v1[3] += bfhi(xi.w);
                    s += ((v0[0] * v0[0] + v0[1] * v0[1]) + (v0[2] * v0[2] + v0[3] * v0[3])) + ((v1[0] * v1[0] + v1[1] * v1[1]) + (v1[2] * v1[2] + v1[3] * v1[3]));
                    u32x4 w; w.x = cvtpk(v0[0], v0[1]); w.y = cvtpk(v0[2], v0[3]); w.z = cvtpk(v1[0], v1[1]); w.w = cvtpk(v1[2], v1[3]);
                    *(u32x4*)(x1b + off + bj * HALF) = w;
                }
                s += __shfl_xor(s, 16); s += __shfl_xor(s, 32);
                if (fq == 0) atomicAdd(rss + row, s);
            }
            asm volatile("" ::: "memory");
        }
    }
};

struct EpiX2 {
    static constexpr bool PERM = true, AFTER_DRAIN = false;
    __device__ __forceinline__ bool keep(const Unit&) const { return false; }
    __device__ __forceinline__ void prefetch(const Unit& u, PG8_LAS unsigned char* lds, int tid) const { prefetch_tile_bf16(this->e, ldc, u.pm * BM, u.pn * BM, lds, tid); }
    const bf16_t* x1b; const bf16_t* e; bf16_t* x2b; const float* rss1; float* rss2; int ldc; float eps;
    __device__ __forceinline__ void operator()(const f32x4 (&acc)[2][2][4][2], const Unit& u, int wr, int wc, int fr, int fq) const {
        const int row0 = u.pm * BM + wr * 64 + fr, col0 = u.pn * BM + wc * 32 + 8 * fq;
#pragma unroll
        for (int ai = 0; ai < 2; ++ai) {
            u32x4 xv[4][2], ev[4][2]; float rv[4];
#pragma unroll
            for (int m = 0; m < 4; ++m) { rv[m] = rss1[row0 + ai * HALF + m * 16];
#pragma unroll
                for (int bj = 0; bj < 2; ++bj) { const size_t off = (size_t)(row0 + ai * HALF + m * 16) * ldc + col0 + bj * HALF; xv[m][bj] = *(const u32x4*)(x1b + off); ev[m][bj] = *(const u32x4*)(e + off); } }
            asm volatile("" ::: "memory");
#pragma unroll
            for (int m = 0; m < 4; ++m) {
                const int row = row0 + ai * HALF + m * 16; const size_t off = (size_t)row * ldc + col0; float s = 0.f;
                const float rstd = 1.0f / sqrtf(rv[m] * (1.0f / 1024.0f) + eps);
#pragma unroll
                for (int bj = 0; bj < 2; ++bj) {
                    const u32x4 xi = xv[m][bj], ei = ev[m][bj];
                    const f32x4 a0 = acc[ai][bj][m][0] * rstd, a1 = acc[ai][bj][m][1] * rstd; f32x4 v0, v1;
                    v0[0] = bflo(xi.x) + sigm_f(a0[0]) * bflo(ei.x); v0[1] = bfhi(xi.x) + sigm_f(a0[1]) * bfhi(ei.x); v0[2] = bflo(xi.y) + sigm_f(a0[2]) * bflo(ei.y); v0[3] = bfhi(xi.y) + sigm_f(a0[3]) * bfhi(ei.y);
                    v1[0] = bflo(xi.z) + sigm_f(a1[0]) * bflo(ei.z); v1[1] = bfhi(xi.z) + sigm_f(a1[1]) * bfhi(ei.z); v1[2] = bflo(xi.w) + sigm_f(a1[2]) * bflo(ei.w); v1[3] = bfhi(xi.w) + sigm_f(a1[3]) * bfhi(ei.w);
                    s += ((v0[0] * v0[0] + v0[1] * v0[1]) + (v0[2] * v0[2] + v0[3] * v0[3])) + ((v1[0] * v1[0] + v1[1] * v1[1]) + (v1[2] * v1[2] + v1[3] * v1[3]));
                    u32x4 w; w.x = cvtpk(v0[0], v0[1]); w.y = cvtpk(v0[2], v0[3]); w.z = cvtpk(v1[0], v1[1]); w.w = cvtpk(v1[2], v1[3]);
                    *(u32x4*)(x2b + off + bj * HALF) = w;
                }
                s += __shfl_xor(s, 16); s += __shfl_xor(s, 32);
                if (fq == 0) atomicAdd(rss2 + row, s);
            }
            asm volatile("" ::: "memory");
        }
    }
};
}
constexpr int NWAVES = 8;
#ifndef MK_N_LAUNCHES
#define MK_N_LAUNCHES 1
#endif
constexpr int N_PHASES = 8;
constexpr int N_LAUNCHES = MK_N_LAUNCHES;

constexpr int BATCH = 8, SEQ = 4096, DM = 1024, M = BATCH * SEQ, AW = 512, NH = 8, HD = 64, PLE = 256, NWIN = 6216, NWP = 6400, CK = 31, TOPK = 256;
constexpr int O_Q = 0, O_KI = 2560, O_WI = 2624, O_GLU = 2632, O_ZB = 3656, O_GA = 4168, O_GB = 5192;
constexpr float EPS = 1e-6f;
constexpr int BT_STRIDE = 160;

constexpr size_t MiB = 1u << 20;
constexpr size_t WS_CTL = 0, CTL_ZERO_BYTES = 1 * MiB;
constexpr size_t WS_RS1 = 512 * 1024, WS_RS2 = 768 * 1024;
constexpr size_t WS_WIN = 2 * MiB;
constexpr size_t WS_WBA = 15 * MiB, WS_WBB = 16 * MiB, WS_WOUT = 17 * MiB, WS_WPG = 19 * MiB, WS_WPP = 21 * MiB;
constexpr size_t WS_BIAS = 21 * MiB + 512 * 1024;
constexpr size_t WS_RS0 = 22 * MiB;
constexpr size_t WS_WI = 23 * MiB;
constexpr size_t WS_KI = 24 * MiB;
constexpr size_t WS_MASK = 28 * MiB;
constexpr size_t WS_PB = 44 * MiB;
constexpr size_t WS_XB = 64 * MiB;
constexpr size_t WS_Q = 128 * MiB, WS_K = 160 * MiB, WS_V = 192 * MiB, WS_ZA = 224 * MiB, WS_QI = 256 * MiB, WS_U = 288 * MiB, WS_ZB = 320 * MiB;
constexpr size_t WS_GA = 352 * MiB, WS_GB = 416 * MiB, WS_END = 480 * MiB;
constexpr int CW_BAR = 4096;

constexpr int RING_BYTES = 131072;
constexpr int LDSCTL_OFF = RING_BYTES, MISC_OFF = LDSCTL_OFF + 320;
constexpr int LDS_BYTES = 161792;

#define GAS __attribute__((address_space(1)))
#define LAS __attribute__((address_space(3)))
typedef unsigned short bf16;
typedef unsigned v4u __attribute__((ext_vector_type(4)));
typedef float f32x4 __attribute__((ext_vector_type(4)));
typedef short bf16x8 __attribute__((ext_vector_type(8)));
typedef GAS unsigned gu32;
typedef GAS unsigned long long gu64;
#define RLX_AGENT __ATOMIC_RELAXED, __HIP_MEMORY_SCOPE_AGENT
#define LDS_WAIT() asm volatile("s_waitcnt lgkmcnt(0)" ::: "memory")
#define VM_WAIT() asm volatile("s_waitcnt vmcnt(0)" ::: "memory")
__device__ __forceinline__ unsigned long long rt() { return __builtin_amdgcn_s_memrealtime(); }
__device__ __forceinline__ unsigned f2bf(float f) { unsigned u = __builtin_bit_cast(unsigned, f); return (u + 0x7fffu + ((u >> 16) & 1u)) >> 16; }
__device__ __forceinline__ unsigned pk2(float lo, float hi) { return f2bf(lo) | (f2bf(hi) << 16); }

#define XB_TMO      128
#define XB_XCNT(j)  (256  + 64 * (j))
#define XB_XSUB(j)  (1280 + 64 * (j))
#define XB_XGEN(j)  (2304 + 64 * (j))
#define XB_TOP      3328
#define XB_TOPGEN   3392
#define XCD_BAR_WORDS 3456
#define XB_SPIN_CAP (1u << 18)

__device__ __forceinline__ unsigned xb_ld(unsigned* p)              { return __hip_atomic_load(p, __ATOMIC_RELAXED, __HIP_MEMORY_SCOPE_AGENT); }
__device__ __forceinline__ unsigned xb_add(unsigned* p, unsigned v) { return __hip_atomic_fetch_add(p, v, __ATOMIC_RELAXED, __HIP_MEMORY_SCOPE_AGENT); }
__device__ __forceinline__ unsigned xb_xcc_id() { return (unsigned)__builtin_amdgcn_s_getreg((3 << 11) | 20) & 0xFu; }
#define XB_SPIN(cond, bar) do { unsigned _sp = 0; while (cond) { __builtin_amdgcn_s_sleep(1); \
    if ((++_sp & 255u) == 0u) { if (xb_ld(&(bar)[XB_TMO])) break; if (_sp > XB_SPIN_CAP) { atomicAdd(&(bar)[XB_TMO], 1u); break; } } } } while (0)

struct XcdBarrier {
    unsigned* bar; unsigned x;
    volatile LAS unsigned* st;
};

__device__ __forceinline__ XcdBarrier xcd_barrier_post(unsigned* bar, volatile LAS unsigned* st) {
    XcdBarrier b; b.bar = bar; b.x = xb_xcc_id(); b.st = st;
    if (threadIdx.x == 0) (void)xb_add(&bar[XB_XCNT(b.x)], 1u);
    return b;
}
__device__ __forceinline__ void xcd_barrier_complete(unsigned* bar, unsigned x, unsigned& nloc, unsigned& nx) {
    const unsigned G = gridDim.x * gridDim.y * gridDim.z;
    unsigned sum, cnt, mine, sp = 0u;
    for (;;) {
        sum = 0u; cnt = 0u; mine = 0u;
#pragma unroll
        for (unsigned j = 0; j < 16; ++j) { const unsigned c = xb_ld(&bar[XB_XCNT(j)]); sum += c; cnt += (c > 0u) ? 1u : 0u; mine = (j == x) ? c : mine; }
        if (sum == G) break;
        __builtin_amdgcn_s_sleep(1);
        if ((++sp & 255u) == 0u) { if (xb_ld(&bar[XB_TMO])) break; if (sp > XB_SPIN_CAP) { atomicAdd(&bar[XB_TMO], 1u); break; } }
    }
    nloc = mine > 0u ? mine : 1u; nx = cnt > 0u ? cnt : 1u;
}

__device__ __forceinline__ void xcd_barrier(const XcdBarrier& b) {
    asm volatile("s_waitcnt vmcnt(0)" ::: "memory");
    __syncthreads();
    if (threadIdx.x == 0) {
        unsigned* bar = b.bar;
        __builtin_amdgcn_s_waitcnt(0);
        unsigned nloc = b.st[0], nx = b.st[1];
        if (nloc == 0u) { xcd_barrier_complete(bar, b.x, nloc, nx); b.st[0] = nloc; b.st[1] = nx; }
        const unsigned old = xb_add(&bar[XB_XSUB(b.x)], 1u);
        const unsigned gen = old / nloc;
        if (old + 1u == (gen + 1u) * nloc) {
            __builtin_amdgcn_fence(__ATOMIC_RELEASE, "agent");
            asm volatile("s_waitcnt vmcnt(0)" ::: "memory");
            const unsigned og = xb_add(&bar[XB_TOP], 1u);
            const unsigned tg = og / nx;
            if (og + 1u == (tg + 1u) * nx) xb_add(&bar[XB_TOPGEN], 1u);
            else XB_SPIN(xb_ld(&bar[XB_TOPGEN]) == tg, bar);
            __builtin_amdgcn_fence(__ATOMIC_ACQUIRE, "agent");
            xb_add(&bar[XB_XGEN(b.x)], 1u);
            asm volatile("s_waitcnt vmcnt(0)" ::: "memory");
        } else {
            XB_SPIN(xb_ld(&bar[XB_XGEN(b.x)]) == gen, bar);
            __builtin_amdgcn_fence(__ATOMIC_ACQUIRE, "agent");
            asm volatile("s_waitcnt vmcnt(0)" ::: "memory");
        }
    }
    __syncthreads();
}
struct Args {
    const float *x, *p, *norm_in_g, *w_in, *conv_w, *conv_b, *conv_ln_g, *conv_ln_b, *w_ba, *w_bb, *w_out, *ple_g, *w_pg, *w_pp, *rel_bias, *fin_g;
    float* out; unsigned char* ws; int ph_lo, ph_hi;
};
typedef float f32x16 __attribute__((ext_vector_type(16)));
typedef unsigned u32x2 __attribute__((ext_vector_type(2)));
__device__ __forceinline__ unsigned cvtpk2(float lo, float hi) { return pg8::cvtpk(lo, hi); }
__device__ __forceinline__ float bf2f(unsigned short h) { return __uint_as_float(((unsigned)h) << 16); }
__device__ __forceinline__ float wave_sum(float v) {
#pragma unroll
    for (int o = 1; o < 64; o <<= 1) v += __shfl_xor(v, o);
    return v;
}
__device__ __forceinline__ int t5_bucket(int rel) {
    const int base = rel > 0 ? 16 : 0; const int n = rel < 0 ? -rel : rel; int v;
    if (n < 8) v = n; else if (n < 12) v = 8; else if (n < 16) v = 9; else if (n < 23) v = 10; else if (n < 32) v = 11; else if (n < 46) v = 12; else if (n < 64) v = 13; else if (n < 91) v = 14; else v = 15;
    return base + v;
}
__device__ __forceinline__ unsigned mono_key(float f) { const unsigned u = __float_as_uint(f); return u ^ ((unsigned)((int)u >> 31) | 0x80000000u); }
__device__ __forceinline__ float relu_i(float x) { const int b = (int)__float_as_uint(x); return __uint_as_float((unsigned)(b > 0 ? b : 0)); }
__device__ __forceinline__ float unmono_key(unsigned k) { return __uint_as_float((k & 0x80000000u) ? (k & 0x7fffffffu) : ~k); }

__device__ __forceinline__ void p0_item(const float* W, int K, int Nsrc, int scol0, int nvalid, const float* g, bf16* WT, int drow0, int k0, LAS float* scr, int lane) {
    const int j = lane & 31, jv = j < nvalid ? j : 0; const float msk = j < nvalid ? 1.f : 0.f;
    const float* wp = W + (size_t)(k0 + (lane >> 5)) * Nsrc + scol0 + jv;
    float v[32];
#pragma unroll
    for (int i = 0; i < 32; ++i) v[i] = wp[(size_t)(2 * i) * Nsrc];
    const int c = lane & 7;
    f32x4 g0 = {1.f, 1.f, 1.f, 1.f}, g1 = g0;
    if (g) { g0 = *(const GAS f32x4*)(g + k0 + 8 * c); g1 = *(const GAS f32x4*)(g + k0 + 8 * c + 4); }
#pragma unroll
    for (int i = 0; i < 32; ++i) scr[(2 * i + (lane >> 5)) * 33 + j] = v[i] * msk;
    LDS_WAIT(); asm volatile("" ::: "memory");
#pragma unroll
    for (int jj = 0; jj < 4; ++jj) { const int n = (lane >> 3) + 8 * jj; const LAS float* s = scr + (8 * c) * 33 + n;
        v4u o; o.x = pk2(s[0 * 33] * g0[0], s[1 * 33] * g0[1]); o.y = pk2(s[2 * 33] * g0[2], s[3 * 33] * g0[3]); o.z = pk2(s[4 * 33] * g1[0], s[5 * 33] * g1[1]); o.w = pk2(s[6 * 33] * g1[2], s[7 * 33] * g1[3]);
        *(GAS v4u*)(WT + (size_t)(drow0 + n) * K + k0 + 8 * c) = o; }
    LDS_WAIT(); asm volatile("" ::: "memory");
}
__device__ __forceinline__ void win_block(int db, int& scol0, int& nvalid) {
    const int pn = db >> 3, sub = db & 7; nvalid = 32;
    if (pn < 10) scol0 = pn * 256 + sub * 32;
    else if (pn < 14) scol0 = O_GLU + (pn - 10) * 128 + (sub < 4 ? sub * 32 : 512 + (sub - 4) * 32);
    else if (pn < 16) scol0 = O_ZB + (pn - 14) * 256 + sub * 32;
    else if (pn < 20) scol0 = O_GA + (pn - 16) * 256 + sub * 32;
    else if (pn < 24) scol0 = O_GB + (pn - 20) * 256 + sub * 32;
    else { if (sub < 2) scol0 = O_KI + sub * 32; else if (sub == 2) { scol0 = O_WI; nvalid = 8; } else { scol0 = 0; nvalid = 0; } }
}
__device__ __forceinline__ void p0_prologue(const Args& A, LAS unsigned char* lds, int vcu, int G) {
    const int tid = threadIdx.x, lane = tid & 63, wave = __builtin_amdgcn_readfirstlane(tid >> 6);
    unsigned char* ws = A.ws;
    LAS float* scr = (LAS float*)(lds + wave * 16384);
    const bool itemw = wave >= 4;
    const int gw = itemw ? vcu * 4 + (wave - 4) : vcu * 4 + wave, NGW = G * 4;
    constexpr int I_IN = 200 * 16, I_BA = 32 * 8, I_BB = 32 * 8, I_OUT = 32 * 16, I_PG = 32 * 16, I_PP = 32 * 4;
    constexpr int NITEMS = I_IN + I_BA + I_BB + I_OUT + I_PG + I_PP;
    if (itemw) for (int it = gw; it < NITEMS; it += NGW) {
        int r = it; const float* W; const float* gsc = nullptr; bf16* WT; int K, Nsrc, sc0, nv = 32, drow0, k0;
        if (r < I_IN) { const int db = r >> 4; win_block(db, sc0, nv); W = A.w_in; K = DM; Nsrc = NWIN; gsc = A.norm_in_g; WT = (bf16*)(ws + WS_WIN); drow0 = db * 32; k0 = (r & 15) * 64; }
        else if ((r -= I_IN) < I_BA) { W = A.w_ba; K = AW; Nsrc = DM; sc0 = (r >> 3) * 32; WT = (bf16*)(ws + WS_WBA); drow0 = sc0; k0 = (r & 7) * 64; }
        else if ((r -= I_BA) < I_BB) { W = A.w_bb; K = AW; Nsrc = DM; sc0 = (r >> 3) * 32; WT = (bf16*)(ws + WS_WBB); drow0 = sc0; k0 = (r & 7) * 64; }
        else if ((r -= I_BB) < I_OUT) { W = A.w_out; K = DM; Nsrc = DM; sc0 = (r >> 4) * 32; WT = (bf16*)(ws + WS_WOUT); drow0 = sc0; k0 = (r & 15) * 64; }
        else if ((r -= I_OUT) < I_PG) { W = A.w_pg; K = DM; Nsrc = DM; sc0 = (r >> 4) * 32; gsc = A.ple_g; WT = (bf16*)(ws + WS_WPG); drow0 = sc0; k0 = (r & 15) * 64; }
        else { r -= I_PG; W = A.w_pp; K = PLE; Nsrc = DM; sc0 = (r >> 2) * 32; WT = (bf16*)(ws + WS_WPP); drow0 = sc0; k0 = (r & 3) * 64; }
        p0_item(W, K, Nsrc, sc0, nv, gsc, WT, drow0, k0, scr, lane);
    }
#ifdef MK_PROBE_A
    if (blockIdx.x == 0 && tid == 0) ((unsigned long long*)(ws + WS_CTL + 256 * 1024))[30] = rt();
#endif
    bf16* XB = (bf16*)(ws + WS_XB); float* RS0 = (float*)(ws + WS_RS0); bf16* PB = (bf16*)(ws + WS_PB);
    if (!itemw) for (int m0 = gw * 4; m0 < M; m0 += NGW * 4) {
        f32x4 v[4][4], pv[4]; float s[4];
#pragma unroll
        for (int r = 0; r < 4; ++r) { const GAS f32x4* xr = (const GAS f32x4*)(A.x + (size_t)(m0 + r) * DM) + lane;
#pragma unroll
            for (int j = 0; j < 4; ++j) v[r][j] = __builtin_nontemporal_load(xr + 64 * j);
            pv[r] = __builtin_nontemporal_load((const GAS f32x4*)(A.p + (size_t)(m0 + r) * PLE) + lane); }
#pragma unroll
        for (int r = 0; r < 4; ++r) { float t = 0.f;
#pragma unroll
            for (int j = 0; j < 4; ++j) t += (v[r][j].x * v[r][j].x + v[r][j].y * v[r][j].y) + (v[r][j].z * v[r][j].z + v[r][j].w * v[r][j].w);
            s[r] = t; }
#pragma unroll
        for (int o = 1; o < 64; o <<= 1) {
#pragma unroll
            for (int r = 0; r < 4; ++r) s[r] += __shfl_xor(s[r], o); }
#pragma unroll
        for (int r = 0; r < 4; ++r) {
            if (lane == 0) RS0[m0 + r] = 1.0f / sqrtf(s[r] * (1.0f / DM) + EPS);
            GAS u32x2* o8 = (GAS u32x2*)(XB + (size_t)(m0 + r) * DM) + lane;
#pragma unroll
            for (int j = 0; j < 4; ++j) { u32x2 w; w.x = cvtpk2(v[r][j].x, v[r][j].y); w.y = cvtpk2(v[r][j].z, v[r][j].w); o8[64 * j] = w; }
            u32x2 w; w.x = cvtpk2(pv[r].x, pv[r].y); w.y = cvtpk2(pv[r].z, pv[r].w);
            ((GAS u32x2*)(PB + (size_t)(m0 + r) * PLE))[lane] = w;
        }
    }
#ifdef MK_PROBE_A
    if (blockIdx.x == 0 && tid == 0) ((unsigned long long*)(ws + WS_CTL + 256 * 1024))[31] = rt();
#endif
    if (vcu == 0) {
        float* BTg = (float*)(ws + WS_BIAS);
        for (int i = tid; i < NH * BT_STRIDE; i += NWAVES * 64) { const int h = i / BT_STRIDE, k = i % BT_STRIDE; const int rel = k - 91; const int bk = t5_bucket(rel < 64 ? rel : 63);
            BTg[i] = (A.rel_bias[bk * NH + h] - A.rel_bias[15 * NH + h]) * 1.4426950408889634f; }
    }
}

__device__ __forceinline__ void conv_phase(const Args& A, LAS unsigned char* lds, int vcu, int G) {
    const int tid = threadIdx.x, lane = tid & 63, wave = __builtin_amdgcn_readfirstlane(tid >> 6);
    const bf16* U = (const bf16*)(A.ws + WS_U); bf16* ZB = (bf16*)(A.ws + WS_ZB);
    LAS float* Y = (LAS float*)(lds + 65536);
    const int c = tid;
    float w[CK];
#pragma unroll
    for (int j = 0; j < CK; ++j) w[j] = A.conv_w[j * 512 + c];
    const float cb = A.conv_b[c];
    f32x4 lg0 = *(const GAS f32x4*)(A.conv_ln_g + 8 * lane), lg1 = *(const GAS f32x4*)(A.conv_ln_g + 8 * lane + 4);
    f32x4 lb0 = *(const GAS f32x4*)(A.conv_ln_b + 8 * lane), lb1 = *(const GAS f32x4*)(A.conv_ln_b + 8 * lane + 4);
    for (int tile = vcu; tile < M / 32; tile += G) {
        const int t0 = tile * 32, pos0 = t0 & (SEQ - 1);
        {
            v4u uv[8];
#pragma unroll
            for (int i = 0; i < 8; ++i) { const int id = tid + 512 * i, row = id >> 6, ch = id & 63; const int rr = (pos0 - 30 + row >= 0 && id < 62 * 64) ? row : 30;
                uv[i] = *(const GAS v4u*)(U + (size_t)(t0 - 30 + rr) * 512 + ch * 8); }
#pragma unroll
            for (int i = 0; i < 8; ++i) { const int id = tid + 512 * i, row = id >> 6, ch = id & 63;
                if (id < 62 * 64) { const v4u z = {0u, 0u, 0u, 0u}; *(LAS v4u*)(lds + row * 1024 + ch * 16) = (pos0 - 30 + row >= 0) ? uv[i] : z; } }
        }
        __syncthreads();
        {
            float uu[62];
#pragma unroll
            for (int i = 0; i < 62; ++i) uu[i] = bf2f(*(const LAS unsigned short*)(lds + i * 1024 + c * 2));
#pragma unroll
            for (int t = 0; t < 32; ++t) { float a = cb;
#pragma unroll
                for (int j = 0; j < CK; ++j) a = fmaf(w[j], uu[t + j], a);
                Y[t * 512 + c] = a; }
        }
        __syncthreads();
        v4u zwv[4];
#pragma unroll
        for (int tt = 0; tt < 4; ++tt) zwv[tt] = *(const GAS v4u*)(ZB + (size_t)(t0 + wave * 4 + tt) * 512 + 8 * lane);
        asm volatile("" ::: "memory");
#pragma unroll
        for (int tt = 0; tt < 4; ++tt) {
            const int t = wave * 4 + tt;
            const f32x4 y0 = *(const LAS f32x4*)(Y + t * 512 + 8 * lane), y1 = *(const LAS f32x4*)(Y + t * 512 + 8 * lane + 4);
            const v4u zw = zwv[tt];
            float s1 = (y0[0] + y0[1]) + (y0[2] + y0[3]) + (y1[0] + y1[1]) + (y1[2] + y1[3]);
            float s2 = (y0[0] * y0[0] + y0[1] * y0[1]) + (y0[2] * y0[2] + y0[3] * y0[3]) + (y1[0] * y1[0] + y1[1] * y1[1]) + (y1[2] * y1[2] + y1[3] * y1[3]);
#pragma unroll
            for (int o = 1; o < 64; o <<= 1) { s1 += __shfl_xor(s1, o); s2 += __shfl_xor(s2, o); }
            const float mu = s1 * (1.0f / 512.0f); float var = s2 * (1.0f / 512.0f) - mu * mu; var = var > 0.f ? var : 0.f;
            const float rs = 1.0f / sqrtf(var + EPS);
            float o_[8];
#pragma unroll
            for (int e = 0; e < 4; ++e) { const float v0 = (y0[e] - mu) * rs * lg0[e] + lb0[e], v1 = (y1[e] - mu) * rs * lg1[e] + lb1[e]; o_[e] = v0 * pg8::sigm_f(v0); o_[4 + e] = v1 * pg8::sigm_f(v1); }
            v4u ow; ow.x = cvtpk2(o_[0] * pg8::bflo(zw.x), o_[1] * pg8::bfhi(zw.x)); ow.y = cvtpk2(o_[2] * pg8::bflo(zw.y), o_[3] * pg8::bfhi(zw.y));
            ow.z = cvtpk2(o_[4] * pg8::bflo(zw.z), o_[5] * pg8::bfhi(zw.z)); ow.w = cvtpk2(o_[6] * pg8::bflo(zw.w), o_[7] * pg8::bfhi(zw.w));
            *(GAS v4u*)(ZB + (size_t)(t0 + t) * 512 + 8 * lane) = ow;
        }
        __syncthreads();
    }
}

#define IDX_SECTION(J0, BODY) if (nj > (J0)) { _Pragma("unroll") for (int j = (J0); j < (J0) + 16; ++j) { BODY } }
#define IDX_FORALL(BODY) do { IDX_SECTION(0, BODY) IDX_SECTION(16, BODY) IDX_SECTION(32, BODY) IDX_SECTION(48, BODY) } while (0)
constexpr int IDX_NB = 256;
constexpr int IDX_HIST_OFF = 132096, IDX_CAND_OFF = IDX_HIST_OFF + 8 * IDX_NB * 4, IDX_QST_OFF = IDX_CAND_OFF + 8 * 128 * 4, IDX_QST_BYTES = 8192 + 256;
static_assert(IDX_QST_OFF + 2 * IDX_QST_BYTES <= LDS_BYTES, "indexer LDS map");
__device__ __forceinline__ void idx_group(int it, int vcu, int G, int& b, int& jg) { if (G == 256) { b = it >> 1; jg = (it & 1) ? 511 - vcu : vcu; } else { const int idx = it * G + vcu; b = idx >> 9; jg = idx & 511; } }
__device__ __forceinline__ void idx_phase(const Args& A, LAS unsigned char* lds, int vcu, int G) {
    const int tid = threadIdx.x, lane = tid & 63, wid = __builtin_amdgcn_readfirstlane(tid >> 6), r32 = lane & 31, hi = lane >> 5;
    const bf16* QI = (const bf16*)(A.ws + WS_QI); const bf16* KI = (const bf16*)(A.ws + WS_KI); const float* WI = (const float*)(A.ws + WS_WI);
    unsigned long long* MASK = (unsigned long long*)(A.ws + WS_MASK);
    LAS unsigned* S = (LAS unsigned*)lds;
    LAS unsigned* HIST = (LAS unsigned*)(lds + IDX_HIST_OFF);
    LAS unsigned* CAND = (LAS unsigned*)(lds + IDX_CAND_OFF) + wid * 128;
    const int ngroups = M / 8; const int nit = (ngroups - vcu + G - 1) / G;
    const int qloc = 2 * ((r32 >> 2) & 1) + (r32 >> 4), hrow = 4 * ((r32 >> 3) & 1) + (r32 & 3);
    for (int i = tid; i < 8 * IDX_NB; i += NWAVES * 64) HIST[i] = 0u;
    v4u nqv = {0u, 0u, 0u, 0u}; f32x4 nwv = {0.f, 0.f, 0.f, 0.f};
    if (nit > 0) { int b0_, j0_; idx_group(0, vcu, G, b0_, j0_); const size_t g0 = (size_t)(b0_ * SEQ + j0_ * 8);
        *(LAS v4u*)(lds + IDX_QST_OFF + tid * 16) = *(const GAS v4u*)(QI + g0 * 512 + tid * 8);
        if (tid < 16) *(LAS f32x4*)(lds + IDX_QST_OFF + 8192 + tid * 16) = *(const GAS f32x4*)(WI + g0 * 8 + tid * 4); }
    if (nit > 1) { int b1_, j1_; idx_group(1, vcu, G, b1_, j1_); const size_t g1 = (size_t)(b1_ * SEQ + j1_ * 8);
        nqv = *(const GAS v4u*)(QI + g1 * 512 + tid * 8); if (tid < 16) nwv = *(const GAS f32x4*)(WI + g1 * 8 + tid * 4); }
    __syncthreads();
    bf16x8 kb0[4], kb1[4], kb2[4], kb3[4]; bool kpre = false;
#define IDX_LOADKB(dst, blk_, nblk_, base_) do { const int bb_ = (blk_) < (nblk_) ? (blk_) : (nblk_) - 1; const bf16* kp_ = (base_) + (size_t)bb_ * 2048; \
        _Pragma("unroll") for (int s = 0; s < 4; ++s) dst[s] = *(const GAS bf16x8*)(kp_ + 512 * s); } while (0)
    for (int it = 0; it < nit; ++it) {
        int b, jg; idx_group(it, vcu, G, b, jg);
        const int pos0 = jg * 8, q0 = b * SEQ + pos0, n = ((pos0 >> 6) + 1) * 64, nj = n >> 6;
        const bool trivial = n <= TOPK;
        if (!trivial) {
            LAS unsigned char* QST = lds + IDX_QST_OFF + (it & 1) * IDX_QST_BYTES; LAS float* WST = (LAS float*)(QST + 8192);
            bf16x8 afr[2][4]; float wv[2][2][8];
#pragma unroll
            for (int g = 0; g < 2; ++g) {
#pragma unroll
                for (int s = 0; s < 4; ++s) afr[g][s] = *(const LAS bf16x8*)(QST + (4 * g + qloc) * 1024 + hrow * 128 + s * 32 + hi * 16);
#pragma unroll
                for (int i = 0; i < 2; ++i) { const LAS f32x4* wp = (const LAS f32x4*)(WST + (4 * g + 2 * hi + i) * 8); const f32x4 w0 = wp[0], w1 = wp[1];
                    wv[g][i][0] = w0[0]; wv[g][i][1] = w0[1]; wv[g][i][2] = w0[2]; wv[g][i][3] = w0[3]; wv[g][i][4] = w1[0]; wv[g][i][5] = w1[1]; wv[g][i][6] = w1[2]; wv[g][i][7] = w1[3]; }
            }
            const int nblk = n >> 5;
            const bf16* KIb = KI + (size_t)(b * (SEQ / 32)) * 2048 + (hi * 32 + r32) * 8;
#define IDX_LOADK(dst, blk_) IDX_LOADKB(dst, blk_, nblk, KIb)
#define IDX_PUT(row_, key_, sc_) do { S[(row_) * 4096 + (key_)] = mono_key(sc_); const float s32_ = (sc_) * 32.0f; int bk_; asm("v_cvt_flr_i32_f32 %0, %1" : "=v"(bk_) : "v"(s32_)); bk_ += IDX_NB / 2; bk_ = bk_ < 0 ? 0 : (bk_ > IDX_NB - 1 ? IDX_NB - 1 : bk_); \
        __hip_atomic_fetch_add(HIST + (row_) * IDX_NB + bk_, 1u, __ATOMIC_RELAXED, __HIP_MEMORY_SCOPE_WORKGROUP); } while (0)
#define IDX_COMP(src, blk_) do { if ((blk_) < nblk) { _Pragma("unroll") for (int g = 0; g < 2; ++g) { \
            f32x16 acc = {0.f, 0.f, 0.f, 0.f, 0.f, 0.f, 0.f, 0.f, 0.f, 0.f, 0.f, 0.f, 0.f, 0.f, 0.f, 0.f}; \
            _Pragma("unroll") for (int s = 0; s < 4; ++s) acc = __builtin_amdgcn_mfma_f32_32x32x16_bf16(afr[g][s], src[s], acc, 0, 0, 0); \
            float s0 = 0.f, s1 = 0.f; \
            _Pragma("unroll") for (int r = 0; r < 8; ++r) { s0 = fmaf(relu_i(acc[r]), wv[g][0][r], s0); s1 = fmaf(relu_i(acc[8 + r]), wv[g][1][r], s1); } \
            IDX_PUT(4 * g + 2 * hi, (blk_) * 32 + r32, s0); IDX_PUT(4 * g + 2 * hi + 1, (blk_) * 32 + r32, s1); } } } while (0)
            if (!kpre) { IDX_LOADK(kb0, wid); IDX_LOADK(kb1, wid + 8); IDX_LOADK(kb2, wid + 16); }
            for (int blk = wid; blk < nblk; blk += 32) {
                IDX_LOADK(kb3, blk + 24); IDX_COMP(kb0, blk);
                IDX_LOADK(kb0, blk + 32); IDX_COMP(kb1, blk + 8);
                IDX_LOADK(kb1, blk + 40); IDX_COMP(kb2, blk + 16);
                IDX_LOADK(kb2, blk + 48); IDX_COMP(kb3, blk + 24);
            }
#undef IDX_LOADK
#undef IDX_COMP
#undef IDX_PUT
        }
        __syncthreads();
        unsigned uk[64]; v4u h0 = {0u, 0u, 0u, 0u};
#pragma unroll
        for (int j = 0; j < 64; ++j) uk[j] = 0u;
        if (!trivial) {
            LAS v4u* H4 = (LAS v4u*)(HIST + wid * IDX_NB) + lane; h0 = H4[0]; const v4u z4 = {0u, 0u, 0u, 0u}; H4[0] = z4;
            LAS unsigned* Sr = S + wid * 4096 + lane;
            { const int jend = (nj + 15) & ~15; for (int jj = nj; jj < jend; ++jj) Sr[64 * jj] = 0u; }
            IDX_FORALL(uk[j] = Sr[64 * j];);
        }
        if (it + 1 < nit) { LAS unsigned char* QN = lds + IDX_QST_OFF + ((it + 1) & 1) * IDX_QST_BYTES; *(LAS v4u*)(QN + tid * 16) = nqv; if (tid < 16) *(LAS f32x4*)(QN + 8192 + tid * 16) = nwv; }
        if (it + 2 < nit) { int b2_, j2_; idx_group(it + 2, vcu, G, b2_, j2_); const size_t g2 = (size_t)(b2_ * SEQ + j2_ * 8);
            nqv = *(const GAS v4u*)(QI + g2 * 512 + tid * 8); if (tid < 16) nwv = *(const GAS f32x4*)(WI + g2 * 8 + tid * 4); }
        asm volatile("s_waitcnt lgkmcnt(0)" ::: "memory");
        __builtin_amdgcn_s_barrier();
        asm volatile("" ::: "memory");
        if (trivial) { MASK[((size_t)(b * 64 + lane) << 12) + pos0 + wid] = lane < nj ? ~0ull : 0ull; continue; }
        {
            int bstar, cabove, cntb;
            {
                const int sl = (int)((h0.x + h0.y) + (h0.z + h0.w));
                int incl = sl;
#pragma unroll
                for (int o = 1; o < 64; o <<= 1) { const int t_ = __shfl_down(incl, o); incl += (lane + o < 64) ? t_ : 0; }
                const int above = incl - sl;
                const unsigned long long pm = __builtin_amdgcn_ballot_w64(above < TOPK && incl >= TOPK);
                const int lsel = (int)__builtin_ctzll(pm | (1ull << 63));
                int abv = __builtin_amdgcn_readlane(above, lsel);
                const int bn0 = __builtin_amdgcn_readlane((int)h0.x, lsel), bn1 = __builtin_amdgcn_readlane((int)h0.y, lsel), bn2 = __builtin_amdgcn_readlane((int)h0.z, lsel), bn3 = __builtin_amdgcn_readlane((int)h0.w, lsel);
                int kk = 3; cntb = bn3;
                if (abv + cntb < TOPK) { abv += cntb; kk = 2; cntb = bn2;
                if (abv + cntb < TOPK) { abv += cntb; kk = 1; cntb = bn1;
                if (abv + cntb < TOPK) { abv += cntb; kk = 0; cntb = bn0; } } }
                bstar = 4 * lsel + kk; cabove = abv;
            }
            const unsigned lo_key = bstar == 0 ? 1u : mono_key((float)(bstar - IDX_NB / 2) * (1.0f / 32.0f));
            const unsigned hi_key = bstar == IDX_NB - 1 ? 0xffffffffu : mono_key((float)(bstar - IDX_NB / 2 + 1) * (1.0f / 32.0f));
            unsigned L = lo_key, H = hi_key; int cH = cabove; bool exact = false; unsigned T = 0u;
            if (cntb <= 128) {
                const unsigned wdt = hi_key - lo_key; int base = 0;
                IDX_FORALL(const bool pr = (uk[j] - lo_key) < wdt; const unsigned long long bm = __builtin_amdgcn_ballot_w64(pr);
                           if (bm) { const int ps = base + (int)__builtin_amdgcn_mbcnt_hi((unsigned)(bm >> 32), __builtin_amdgcn_mbcnt_lo((unsigned)bm, 0u));
                                     if (pr) CAND[ps & 127] = uk[j]; base += __builtin_popcountll(bm); });
                const unsigned ck0 = (lane < cntb) ? CAND[lane] : 0u, ck1 = (lane + 64 < cntb) ? CAND[lane + 64] : 0u;
                const int r = TOPK - cabove;
                unsigned l2 = lo_key, h2 = hi_key;
                while (h2 - l2 > 1u) { const unsigned md = l2 + ((h2 - l2) >> 1); const int c = __builtin_popcountll(__builtin_amdgcn_ballot_w64(ck0 >= md)) + __builtin_popcountll(__builtin_amdgcn_ballot_w64(ck1 >= md)); if (c >= r) l2 = md; else h2 = md; }
                const int cge = __builtin_popcountll(__builtin_amdgcn_ballot_w64(ck0 >= l2)) + __builtin_popcountll(__builtin_amdgcn_ballot_w64(ck1 >= l2));
                if (cge == r) { exact = true; T = l2; } else { L = l2; H = l2 + 1u; cH = cabove + __builtin_popcountll(__builtin_amdgcn_ballot_w64(ck0 > l2)) + __builtin_popcountll(__builtin_amdgcn_ballot_w64(ck1 > l2)); }
            }
            for (int iter = 0; !exact && iter < 96 && H - L > 1u; ++iter) {
                unsigned mid = L + ((H - L) >> 1);
                if (iter < 24) { const float fm = 0.5f * (unmono_key(L) + unmono_key(H)); const unsigned km = mono_key(fm); if (km > L && km < H) mid = km; }
                mid = (unsigned)__builtin_amdgcn_readfirstlane((int)mid);
                int ca = 0, cb = 0;
                IDX_FORALL(if (j & 1) cb += (uk[j] >= mid) ? 1 : 0; else ca += (uk[j] >= mid) ? 1 : 0;);
                ca += cb; int c = 0;
#pragma unroll
                for (int bt = 0; bt < 7; ++bt) c += __builtin_popcountll(__builtin_amdgcn_ballot_w64(((ca >> bt) & 1) != 0)) << bt;
                if (c == TOPK) { T = mid; exact = true; break; }
                if (c > TOPK) L = mid; else { H = mid; cH = c; }
            }
            unsigned wlo = 0u, whi = 0u;
            int lane_o = lane; asm volatile("" : "+v"(lane_o));
            if (exact) {
                IDX_FORALL(const unsigned long long bm = __builtin_amdgcn_ballot_w64(uk[j] >= T); if (lane_o == j) { wlo = (unsigned)bm; whi = (unsigned)(bm >> 32); });
            } else {
                const int need = TOPK - cH; int run = 0;
                IDX_FORALL(const bool eq = uk[j] == L; const unsigned long long be = __builtin_amdgcn_ballot_w64(eq);
                           const int rk = run + (int)__builtin_amdgcn_mbcnt_hi((unsigned)(be >> 32), __builtin_amdgcn_mbcnt_lo((unsigned)be, 0u));
                           const bool sel = (uk[j] > L) || (eq && rk < need);
                           const unsigned long long bm = __builtin_amdgcn_ballot_w64(sel); run += __builtin_popcountll(be);
                           if (lane_o == j) { wlo = (unsigned)bm; whi = (unsigned)(bm >> 32); });
            }
            MASK[((size_t)(b * 64 + lane) << 12) + pos0 + wid] = ((unsigned long long)whi << 32) | wlo;
        }
    }
    __syncthreads();
#undef IDX_LOADKB
}
#undef IDX_SECTION
#undef IDX_FORALL

__device__ __forceinline__ void attn_phase(const Args& A, LAS unsigned char* lds, int vcu, int G) {
    const int tid = threadIdx.x, lane = tid & 63, wid = __builtin_amdgcn_readfirstlane(tid >> 6), r32 = lane & 31, hi = lane >> 5;
    bf16* Qb = (bf16*)(A.ws + WS_Q); const bf16* Kg = (const bf16*)(A.ws + WS_K); const bf16* Vg = (const bf16*)(A.ws + WS_V); const bf16* ZA = (const bf16*)(A.ws + WS_ZA);
    const unsigned long long* MASK = (const unsigned long long*)(A.ws + WS_MASK);
    constexpr int KB0 = 0, VT0 = 16384, VP = 192, VTB = 64 * VP, BTO = VT0 + 2 * VTB;
    LAS float* BT = (LAS float*)(lds + BTO);
    { const float* BTg = (const float*)(A.ws + WS_BIAS); for (int i = tid; i < NH * BT_STRIDE; i += NWAVES * 64) BT[i] = BTg[i]; }
    __syncthreads();
    const int lkv = tid >> 3, lch = tid & 7;
    const int kst = lkv * 128 + ((lch ^ ((lkv >> 1) & 7)) << 4), vst = lkv * VP + lch * 16;
    const int vrd = (4 * hi + ((lane & 15) >> 2)) * VP + (16 * ((lane >> 4) & 1) + 4 * (lane & 3)) * 2;
    const int nunits = BATCH * NH * (SEQ / 256);
    for (int iu = 0;; ++iu) {
        const int ui = iu * G + vcu; if (ui >= nunits) break;
        int bh, qb;
        if (G == 256) { bh = vcu >> 2; const int s = vcu & 3; qb = (iu == 0) ? s : (iu == 1) ? 7 - s : (iu == 2) ? 8 + s : 15 - s; } else { bh = ui >> 4; qb = ui & 15; }
        const int b = bh >> 3, h = bh & 7, q0 = qb * 256, tokb = b * SEQ, NT = 4 * qb + 4, cw = 4 * qb + (wid >> 1);
        const int myq = q0 + 32 * wid + r32; const size_t tokq = (size_t)(tokb + myq);
        bf16x8 qf[4];
#pragma unroll
        for (int d0 = 0; d0 < 4; ++d0) qf[d0] = *(const GAS bf16x8*)(Qb + tokq * 512 + h * 64 + 16 * d0 + 8 * hi);
        float m = 0.f, l = 0.f;
        f32x16 ot0 = {0.f, 0.f, 0.f, 0.f, 0.f, 0.f, 0.f, 0.f, 0.f, 0.f, 0.f, 0.f, 0.f, 0.f, 0.f, 0.f}, ot1 = ot0;
        const bf16* kptr = Kg + (size_t)(tokb + lkv) * 512 + h * 64 + lch * 8;
        const bf16* vptr = Vg + (size_t)(tokb + lkv) * 512 + h * 64 + lch * 8;
        v4u kr = *(const GAS v4u*)kptr, vr = *(const GAS v4u*)vptr;
#define ATT_WRITE(buf) do { *(LAS v4u*)(lds + KB0 + (buf) * 8192 + kst) = kr; *(LAS v4u*)(lds + VT0 + (buf) * VTB + vst) = vr; } while (0)
        ATT_WRITE(0);
        if (NT > 1) { kr = *(const GAS v4u*)(kptr + (size_t)64 * 512); vr = *(const GAS v4u*)(vptr + (size_t)64 * 512); }
        const unsigned long long* mrow = MASK + ((size_t)(b * 64) << 12) + myq;
        unsigned long long mw = mrow[0];
        f32x16 nm = {0.f, 0.f, 0.f, 0.f, 0.f, 0.f, 0.f, 0.f, 0.f, 0.f, 0.f, 0.f, 0.f, 0.f, 0.f, 0.f};
        __syncthreads();
        for (int t = 0; t < NT; ++t) {
            const int cur = t & 1;
            unsigned mlo = (unsigned)mw >> (4 * hi), mhi = (unsigned)(mw >> 32) >> (4 * hi);
            asm volatile("" : "+v"(mlo), "+v"(mhi) :: "memory");
            if (t + 1 < NT) ATT_WRITE(cur ^ 1);
            asm volatile("" ::: "memory");
            if (t + 2 < NT) { kr = *(const GAS v4u*)(kptr + (size_t)(t + 2) * 64 * 512); vr = *(const GAS v4u*)(vptr + (size_t)(t + 2) * 64 * 512); }
            if (t + 1 < NT) mw = mrow[(size_t)(t + 1) << 12];
            if (t <= cw) {
                const LAS unsigned char* kb = lds + KB0 + cur * 8192; const LAS unsigned char* vt = lds + VT0 + cur * VTB;
                f32x16 p0 = nm, p1 = nm;
#pragma unroll
                for (int d0 = 0; d0 < 4; ++d0) {
                    const int sw = ((2 * d0 + hi) ^ ((r32 >> 1) & 7)) << 4;
                    const bf16x8 a0 = *(const LAS bf16x8*)(kb + r32 * 128 + sw), a1 = *(const LAS bf16x8*)(kb + (32 + r32) * 128 + sw);
                    p0 = __builtin_amdgcn_mfma_f32_32x32x16_bf16(a0, qf[d0], p0, 0, 0, 0);
                    p1 = __builtin_amdgcn_mfma_f32_32x32x16_bf16(a1, qf[d0], p1, 0, 0, 0);
                }
                if (64 * t + 63 >= q0 + 32 * wid - 90) {
                    const int base = 64 * t + 4 * hi - myq + 91; const LAS float* bt = BT + h * BT_STRIDE;
#pragma unroll
                    for (int r = 0; r < 16; ++r) { const int cr = (r & 3) + 8 * (r >> 2); int i0 = base + cr, i1 = base + 32 + cr; i0 = i0 < 0 ? 0 : i0; i1 = i1 < 0 ? 0 : i1; p0[r] += bt[i0]; p1[r] += bt[i1]; }
                }
                if ((t & 3) == 0) {
                float mx;
                { float xa = __builtin_fmaxf(__builtin_fmaxf(p0[0], p0[1]), p1[0]), xb = __builtin_fmaxf(__builtin_fmaxf(p0[2], p0[3]), p1[1]); xa = __builtin_fmaxf(__builtin_fmaxf(xa, p1[2]), p1[3]);
#pragma unroll
                  for (int r = 4; r < 16; r += 4) { xa = __builtin_fmaxf(__builtin_fmaxf(xa, p0[r]), p0[r + 1]); xb = __builtin_fmaxf(__builtin_fmaxf(xb, p0[r + 2]), p0[r + 3]); xa = __builtin_fmaxf(__builtin_fmaxf(xa, p1[r]), p1[r + 1]); xb = __builtin_fmaxf(__builtin_fmaxf(xb, p1[r + 2]), p1[r + 3]); }
                  mx = __builtin_fmaxf(xa, xb); }
                mx = __builtin_fmaxf(mx, __shfl_xor(mx, 32));
                if (t == 0 || __any(mx > 4.0f)) {
                    const float dl = (t == 0) ? mx : __builtin_fmaxf(mx, 0.f), al = (t == 0) ? 0.f : __builtin_amdgcn_exp2f(-dl); m += dl; l *= al;
#pragma unroll
                    for (int r = 0; r < 16; ++r) { p0[r] -= dl; p1[r] -= dl; ot0[r] *= al; ot1[r] *= al; nm[r] = -m; }
                }
                }
                float ps = 0.f, ps2 = 0.f;
#pragma unroll
                for (int r = 0; r < 16; ++r) { const int cr = (r & 3) + 8 * (r >> 2);
                    unsigned b0_, b1_; asm("v_bfe_i32 %0, %1, %2, 1" : "=v"(b0_) : "v"(mlo), "i"(cr)); asm("v_bfe_i32 %0, %1, %2, 1" : "=v"(b1_) : "v"(mhi), "i"(cr));
                    const float e0 = __uint_as_float(__float_as_uint(__builtin_amdgcn_exp2f(p0[r])) & b0_);
                    const float e1 = __uint_as_float(__float_as_uint(__builtin_amdgcn_exp2f(p1[r])) & b1_);
                    p0[r] = e0; p1[r] = e1; ps += e0; ps2 += e1; }
                ps += ps2;
                l += ps;
#pragma unroll
                for (int s = 0; s < 4; ++s) {
                    v4u pw;
                    if (s == 0) { pw.x = cvtpk2(p0[0], p0[1]); pw.y = cvtpk2(p0[2], p0[3]); pw.z = cvtpk2(p0[4], p0[5]); pw.w = cvtpk2(p0[6], p0[7]); }
                    else if (s == 1) { pw.x = cvtpk2(p0[8], p0[9]); pw.y = cvtpk2(p0[10], p0[11]); pw.z = cvtpk2(p0[12], p0[13]); pw.w = cvtpk2(p0[14], p0[15]); }
                    else if (s == 2) { pw.x = cvtpk2(p1[0], p1[1]); pw.y = cvtpk2(p1[2], p1[3]); pw.z = cvtpk2(p1[4], p1[5]); pw.w = cvtpk2(p1[6], p1[7]); }
                    else { pw.x = cvtpk2(p1[8], p1[9]); pw.y = cvtpk2(p1[10], p1[11]); pw.z = cvtpk2(p1[12], p1[13]); pw.w = cvtpk2(p1[14], p1[15]); }
                    const bf16x8 pb = __builtin_bit_cast(bf16x8, pw);
                    typedef short v4i16_t __attribute__((ext_vector_type(4)));
                    const LAS unsigned char* vrow = vt + vrd + (16 * s) * VP;
                    const v4i16_t lo0 = __builtin_amdgcn_ds_read_tr16_b64_v4i16((LAS v4i16_t*)(vrow)), hi0 = __builtin_amdgcn_ds_read_tr16_b64_v4i16((LAS v4i16_t*)(vrow + 8 * VP));
                    const v4i16_t lo1 = __builtin_amdgcn_ds_read_tr16_b64_v4i16((LAS v4i16_t*)(vrow + 64)), hi1 = __builtin_amdgcn_ds_read_tr16_b64_v4i16((LAS v4i16_t*)(vrow + 8 * VP + 64));
                    const bf16x8 a0w = {lo0[0], lo0[1], lo0[2], lo0[3], hi0[0], hi0[1], hi0[2], hi0[3]}, a1w = {lo1[0], lo1[1], lo1[2], lo1[3], hi1[0], hi1[1], hi1[2], hi1[3]};
                    ot0 = __builtin_amdgcn_mfma_f32_32x32x16_bf16(a0w, pb, ot0, 0, 0, 0);
                    ot1 = __builtin_amdgcn_mfma_f32_32x32x16_bf16(a1w, pb, ot1, 0, 0, 0);
                }
            }
            __syncthreads();
        }
#undef ATT_WRITE
        const float lt = l + __shfl_xor(l, 32); const float inv = 1.0f / lt;
        u32x2 zw[8];
#pragma unroll
        for (int i = 0; i < 8; ++i) zw[i] = *(const GAS u32x2*)(ZA + tokq * 512 + h * 64 + 32 * (i >> 2) + 8 * (i & 3) + 4 * hi);
        asm volatile("" ::: "memory");
#pragma unroll
        for (int i = 0; i < 8; ++i) {
            const int g = i & 3; const size_t off = tokq * 512 + h * 64 + 32 * (i >> 2) + 8 * g + 4 * hi;
            const float o0 = ((i >> 2) ? ot1[4 * g] : ot0[4 * g]) * inv, o1 = ((i >> 2) ? ot1[4 * g + 1] : ot0[4 * g + 1]) * inv, o2 = ((i >> 2) ? ot1[4 * g + 2] : ot0[4 * g + 2]) * inv, o3 = ((i >> 2) ? ot1[4 * g + 3] : ot0[4 * g + 3]) * inv;
            u32x2 w; w.x = cvtpk2(o0 * pg8::bflo(zw[i].x), o1 * pg8::bfhi(zw[i].x)); w.y = cvtpk2(o2 * pg8::bflo(zw[i].y), o3 * pg8::bfhi(zw[i].y));
            *(GAS u32x2*)(Qb + off) = w;
        }
    }
}

__device__ __forceinline__ void final_phase(const Args& A, int vcu, int G) {
    const int tid = threadIdx.x, lane = tid & 63, wave = __builtin_amdgcn_readfirstlane(tid >> 6);
    const int gw = vcu * NWAVES + wave, NGW = G * NWAVES;
    const float* RS2 = (const float*)(A.ws + WS_RS2);
    f32x4 g[4];
#pragma unroll
    for (int j = 0; j < 4; ++j) g[j] = ((const GAS f32x4*)A.fin_g)[lane + 64 * j];
    const bf16* X2B = (const bf16*)(A.ws + WS_XB);
    for (int m0 = gw * 4; m0 < M; m0 += NGW * 4) {
        u32x2 w[4][4]; float r[4];
#pragma unroll
        for (int q = 0; q < 4; ++q) { r[q] = RS2[m0 + q]; const GAS u32x2* xi = (const GAS u32x2*)(X2B + (size_t)(m0 + q) * DM) + lane;
#pragma unroll
            for (int j = 0; j < 4; ++j) w[q][j] = __builtin_nontemporal_load(xi + 64 * j); }
        asm volatile("" ::: "memory");
#pragma unroll
        for (int q = 0; q < 4; ++q) { const float rs = 1.0f / sqrtf(r[q] * (1.0f / DM) + EPS); GAS f32x4* xo = (GAS f32x4*)(A.out + (size_t)(m0 + q) * DM) + lane;
#pragma unroll
            for (int j = 0; j < 4; ++j) { f32x4 v; v.x = pg8::bflo(w[q][j].x); v.y = pg8::bfhi(w[q][j].x); v.z = pg8::bflo(w[q][j].y); v.w = pg8::bfhi(w[q][j].y); __builtin_nontemporal_store(v * rs * g[j], xo + 64 * j); } }
    }
}
__global__ void __launch_bounds__(NWAVES * 64, 2) mk_fwd(Args args) {
    extern __shared__ __attribute__((aligned(16))) unsigned char lds_raw[];
    LAS unsigned char* lds = (LAS unsigned char*)lds_raw;
    volatile LAS unsigned* MISC = (volatile LAS unsigned*)(lds + MISC_OFF);
    const int tid = threadIdx.x;
    const int G = gridDim.x; int vcu; { const int bx = blockIdx.x; vcu = (G % 8 == 0) ? (bx % 8) * (G / 8) + bx / 8 : bx; }
    unsigned char* ws = args.ws;
    gu32* ctl = (gu32*)(ws + WS_CTL);
    for (int u = tid; u < (LDS_BYTES - LDSCTL_OFF) / 4; u += NWAVES * 64) ((LAS unsigned*)(lds + LDSCTL_OFF))[u] = 0u;
    __syncthreads();
    XcdBarrier bar; bar.bar = (unsigned*)(ctl + CW_BAR); bar.x = 0; bar.st = nullptr;
    if (N_LAUNCHES == 1) bar = xcd_barrier_post((unsigned*)(ctl + CW_BAR), MISC + 8);
#define GRID_BAR() do { if (N_LAUNCHES == 1) xcd_barrier(bar); } while (0)
    const int lo = args.ph_lo, hi = args.ph_hi;
#ifndef MK_PHASE_MASK
#define MK_PHASE_MASK 0xff
#endif
#define IN(k) ((((MK_PHASE_MASK) >> (k)) & 1) && lo <= (k) && (k) < hi)
#define BOTH(k) (IN(k) && IN((k) + 1))
    bf16* XB = (bf16*)(ws + WS_XB);
#ifdef MK_PROBE_A
    unsigned long long* ts = (unsigned long long*)(ws + WS_CTL + 256 * 1024);
#define STAMP(k) do { if (blockIdx.x == 0 && tid == 0) ts[k] = rt(); } while (0)
#else
#define STAMP(k) do { } while (0)
#endif
    STAMP(0);
    if (IN(0)) { p0_prologue(args, lds, vcu, G); if (BOTH(0)) GRID_BAR(); STAMP(1); }
    if (IN(1)) {
        pg8::Gemm g{XB, (const bf16*)(ws + WS_WIN), M, NWP, DM}; pg8::StaticOrder S; S.init(M, NWP, G, (int)blockIdx.x);
        pg8::EpiP1 E{(const float*)(ws + WS_RS0), (bf16*)(ws + WS_Q), (bf16*)(ws + WS_K), (bf16*)(ws + WS_V), (bf16*)(ws + WS_ZA), (bf16*)(ws + WS_QI), (bf16*)(ws + WS_U), (bf16*)(ws + WS_ZB),
                     (bf16*)(ws + WS_GA), (bf16*)(ws + WS_GB), (bf16*)(ws + WS_KI), (float*)(ws + WS_WI)};
        pg8::gemm_phase<pg8::EpiP1, pg8::StaticOrder, PG8_ALIGN, PG8_SP2>(lds, g, S, E);
        if (BOTH(1)) GRID_BAR();
        STAMP(2);
    }
    if (IN(2)) { conv_phase(args, lds, vcu, G); STAMP(9); idx_phase(args, lds, vcu, G); if (BOTH(2)) GRID_BAR(); STAMP(3); }
    if (IN(3)) { attn_phase(args, lds, vcu, G); if (BOTH(3)) GRID_BAR(); STAMP(4); }
    if (IN(4)) {
#ifndef MK_P4_MASK
#define MK_P4_MASK 7
#endif
        if (MK_P4_MASK & 1) {
            static_assert((WS_ZB - WS_Q) % ((size_t)256 * AW * 2) == 0 && (WS_WBB - WS_WBA) % ((size_t)256 * AW * 2) == 0, "second operand pair must sit a whole number of 256-row tiles behind the first");
            constexpr int DPM = (int)((WS_ZB - WS_Q) / ((size_t)256 * AW * 2)), DPN = (int)((WS_WBB - WS_WBA) / ((size_t)256 * AW * 2));
            pg8::Gemm g{(const bf16*)(ws + WS_Q), (const bf16*)(ws + WS_WBA), M, DM, AW}; pg8::PairOrder S; S.so.init(M, DM, G, (int)blockIdx.x); S.dpm = DPM; S.dpn = DPN;
            pg8::EpiBranch E{(const bf16*)(ws + WS_GA), (const bf16*)(ws + WS_GB), (bf16*)(ws + WS_K), DM, DPM, DPN};
            pg8::gemm_phase<pg8::EpiBranch, pg8::PairOrder, PG8_ALIGN, PG8_SP2>(lds, g, S, E); }
        if (MK_P4_MASK & 4) { int kple = PLE; asm volatile("" : "+s"(kple));
          pg8::Gemm g{(const bf16*)(ws + WS_PB), (const bf16*)(ws + WS_WPP), M, DM, kple}; pg8::StaticOrder S; S.init(M, DM, G, (int)blockIdx.x);
          pg8::EpiPlain E{(bf16*)(ws + WS_GB), DM};
          pg8::gemm_phase<pg8::EpiPlain, pg8::StaticOrder, PG8_ALIGN, PG8_SP2>(lds, g, S, E); }
        if (BOTH(4)) GRID_BAR();
        STAMP(5);
    }
    if (IN(5)) {
        pg8::Gemm g{(const bf16*)(ws + WS_K), (const bf16*)(ws + WS_WOUT), M, DM, DM}; pg8::StaticOrder S; S.init(M, DM, G, (int)blockIdx.x);
        pg8::EpiX1 E{XB, (bf16*)(ws + WS_GA), (float*)(ws + WS_RS1), DM};
        pg8::gemm_phase<pg8::EpiX1, pg8::StaticOrder, PG8_ALIGN, PG8_SP2>(lds, g, S, E);
        if (BOTH(5)) GRID_BAR();
        STAMP(6);
    }
    if (IN(6)) {
        pg8::Gemm g{(const bf16*)(ws + WS_GA), (const bf16*)(ws + WS_WPG), M, DM, DM}; pg8::StaticOrder S; S.init(M, DM, G, (int)blockIdx.x);
        pg8::EpiX2 E{(const bf16*)(ws + WS_GA), (const bf16*)(ws + WS_GB), XB, (const float*)(ws + WS_RS1), (float*)(ws + WS_RS2), DM, EPS};
        pg8::gemm_phase<pg8::EpiX2, pg8::StaticOrder, PG8_ALIGN, PG8_SP2>(lds, g, S, E);
        if (BOTH(6)) GRID_BAR();
        STAMP(7);
    }
    if (IN(7)) final_phase(args, vcu, G);
#ifdef MK_PROBE_A
    if (blockIdx.x == 0 && tid == 0) { const unsigned long long t8 = rt(); const unsigned long long dt = ts[MK_PROBE_HI] - ts[MK_PROBE_LO]; while (rt() < t8 + (unsigned long long)MK_PROBE_MULT * dt) __builtin_amdgcn_s_sleep(32); }
#endif
#undef IN
#undef BOTH
#undef GRID_BAR
}

extern "C" void kernel_launch(void* const* d_in, const int* in_sizes, int n_in, void* d_out, int out_size, void* d_ws, size_t ws_size, hipStream_t stream) {
    static int grid = 0;
    if (grid == 0) {
        if (n_in != 16 || out_size != M * DM || ws_size < WS_END) { fprintf(stderr, "kernel_launch: unexpected problem (n_in %d, out %d, ws %zu); nothing launched\n", n_in, out_size, ws_size); grid = -1; return; }
        int dev = 0, cus = 0, per_cu = 0;
        if (hipGetDevice(&dev) != hipSuccess || hipDeviceGetAttribute(&cus, hipDeviceAttributeMultiprocessorCount, dev) != hipSuccess) { grid = -1; return; }
        if (hipFuncSetAttribute((const void*)mk_fwd, hipFuncAttributeMaxDynamicSharedMemorySize, LDS_BYTES) != hipSuccess) { fprintf(stderr, "kernel_launch: hipFuncSetAttribute failed\n"); grid = -1; return; }
        if (hipOccupancyMaxActiveBlocksPerMultiprocessor(&per_cu, (const void*)mk_fwd, NWAVES * 64, LDS_BYTES) != hipSuccess || per_cu < 1) { fprintf(stderr, "kernel_launch: occupancy query says %d blocks per CU\n", per_cu); per_cu = 1; }
        (void)hipGetLastError();
        grid = cus;
    }
    if (grid < 0) return;
    if (hipMemsetAsync((char*)d_ws + WS_CTL, 0, CTL_ZERO_BYTES, stream) != hipSuccess) { fprintf(stderr, "kernel_launch: memset failed\n"); return; }
    Args a{};
    a.x = (const float*)d_in[0]; a.p = (const float*)d_in[1]; a.norm_in_g = (const float*)d_in[2]; a.w_in = (const float*)d_in[3]; a.conv_w = (const float*)d_in[4]; a.conv_b = (const float*)d_in[5];
    a.conv_ln_g = (const float*)d_in[6]; a.conv_ln_b = (const float*)d_in[7]; a.w_ba = (const float*)d_in[8]; a.w_bb = (const float*)d_in[9]; a.w_out = (const float*)d_in[10]; a.ple_g = (const float*)d_in[11];
    a.w_pg = (const float*)d_in[12]; a.w_pp = (const float*)d_in[13]; a.rel_bias = (const float*)d_in[14]; a.fin_g = (const float*)d_in[15];
    a.out = (float*)d_out; a.ws = (unsigned char*)d_ws;
    for (int li = 0; li < N_LAUNCHES; ++li) {
        if (N_LAUNCHES == 1) { a.ph_lo = 0; a.ph_hi = N_PHASES; } else { a.ph_lo = li; a.ph_hi = li + 1; }
        if (N_LAUNCHES == 1) {
            void* kargs[] = {&a};
            hipError_t e = hipLaunchCooperativeKernel((const void*)mk_fwd, dim3(grid), dim3(NWAVES * 64), kargs, LDS_BYTES, stream);
            if (e != hipSuccess) { (void)hipGetLastError(); fprintf(stderr, "kernel_launch: cooperative launch failed (%s); plain launch instead\n", hipGetErrorName(e)); hipLaunchKernelGGL(mk_fwd, dim3(grid), dim3(NWAVES * 64), LDS_BYTES, stream, a); }
        } else {
            hipLaunchKernelGGL(mk_fwd, dim3(grid), dim3(NWAVES * 64), LDS_BYTES, stream, a);
        }
        const hipError_t le = hipPeekAtLastError();
        if (le != hipSuccess) { fprintf(stderr, "kernel_launch: launch %d failed: %s\n", li, hipGetErrorName(le)); break; }
    }
}
```

```cpp
#include <hip/hip_runtime.h>
#include <cstdio>
#include <cstdint>
#define MK_N_LAUNCHES 1
namespace pg8 {
#define PG8_LAS __attribute__((address_space(3)))
typedef unsigned short bf16_t;
typedef short bf16x8 __attribute__((ext_vector_type(8)));
typedef float f32x4 __attribute__((ext_vector_type(4)));
typedef unsigned u32x4 __attribute__((ext_vector_type(4)));
constexpr int BM = 256, BK = 64, HALF = 128, HTB = HALF * BK * 2  , STAGE_BYTES = 8 * HTB, NXCD = 8, WGM = 8;

__host__ __device__ __forceinline__ int lds_byte(int r, int c) { const int st = (r >> 4) * 2 + (c >> 5), rr = r & 15, cc = c & 31, ob = rr * 64 + cc * 2; return st * 1024 + (ob ^ (((ob >> 9) & 1) << 5)); }
__host__ __device__ __forceinline__ void stage_rc(int b, int& R, int& C) { const int st = b / 1024, sb = b % 1024, swz = sb ^ (((sb >> 9) & 1) << 5); R = (st >> 1) * 16 + swz / 64; C = (st & 1) * 32 + (swz % 64) / 2; }
__host__ __device__ __forceinline__ int perm32(int rho) { const int n = rho >> 4, i = rho & 15; return 8 * (i >> 2) + 4 * n + (i & 3); }

struct Unit { int pm, pn; };
struct Gemm { const bf16_t* A; const bf16_t* Bt; int M, N, K; };

struct StaticOrder {
    int nM, nN, nwg, G, c;
    __host__ __device__ void init(int M, int N, int G_, int c_) { nM = M / BM; nN = N / BM; nwg = nM * nN; G = G_; c = c_; }
    __host__ __device__ bool next(int i, Unit& u) const {
        const long L = (long)i * G + c; if (L >= nwg) return false;
        int wgid = (int)L; { const int q = nwg / NXCD, r = nwg % NXCD, xcd = wgid % NXCD, off = wgid / NXCD; wgid = (xcd < r ? xcd * (q + 1) : r * (q + 1) + (xcd - r) * q) + off; }
        const int nig = WGM * nN, gid = wgid / nig, fm = gid * WGM, gsz = (nM - fm) < WGM ? (nM - fm) : WGM;
        u.pm = fm + ((wgid % nig) % gsz); u.pn = (wgid % nig) / gsz; return true;
    }
    __device__ __forceinline__ void a_ready(const Unit&) const {}
    __device__ __forceinline__ void done(const Unit&) const {}
};

__device__ __forceinline__ unsigned cvt_pk_bf16(float lo, float hi) { unsigned r; asm volatile("v_cvt_pk_bf16_f32 %0, %1, %2" : "=v"(r) : "v"(lo), "v"(hi)); return r; }
typedef float f32x2 __attribute__((ext_vector_type(2)));
template <class Epi, class Sched, bool ALIGN_EPI = false, bool SP2 = false>
__device__ __forceinline__ void gemm_phase(PG8_LAS unsigned char* lds, const Gemm g, const Sched& S, const Epi& E) {
    const int tid = threadIdx.x, wid = __builtin_amdgcn_readfirstlane(tid >> 6), lane = tid & 63, wr = wid >> 2, wc = wid & 3, fr = lane & 15, fq = lane >> 4;
    const int K = g.K, nt = K / BK;
    unsigned voffA[2], voffB[2];
#pragma unroll
    for (int i = 0; i < 2; ++i) { int R, C; stage_rc(tid * 16 + i * 8192, R, C); const int Rb = Epi::PERM ? ((R & ~31) + perm32(R & 31)) : R;
        voffA[i] = (unsigned)(R * K + C) * 2u; voffB[i] = (unsigned)(Rb * K + C) * 2u; }
    const size_t kstep = (size_t)(BK * 2);
    const size_t hstep = (size_t)HALF * K * 2;
    const size_t tstep = 2 * hstep;
    const unsigned ldsw = (unsigned)wid * 1024u;
    const int aoff = lds_byte(wr * 64 + fr, fq * 8), boff = lds_byte(wc * 32 + fr, fq * 8);
#define PG8_SA(b, h) (((b) * 2 + (h)) * HTB)
#define PG8_SB(b, h) ((4 + (b) * 2 + (h)) * HTB)
#define PG8_STAGE(bufoff, gbase, voff) do { _Pragma("unroll") for (int _i = 0; _i < 2; ++_i) \
        __builtin_amdgcn_global_load_lds((const unsigned*)((const char*)(gbase) + (voff)[_i]), (PG8_LAS unsigned*)(lds + (bufoff) + ldsw + _i * 8192), 16, 0, 0); } while (0)
#define PG8_LDA(dst, b, h) do { _Pragma("unroll") for (int m = 0; m < 4; ++m) _Pragma("unroll") for (int k = 0; k < 2; ++k) dst[m][k] = *(const PG8_LAS bf16x8*)(lds + PG8_SA(b, h) + aoff + m * 2048 + k * 1024); } while (0)
#define PG8_LDB(dst, b, h) do { _Pragma("unroll") for (int n = 0; n < 2; ++n) _Pragma("unroll") for (int k = 0; k < 2; ++k) dst[n][k] = *(const PG8_LAS bf16x8*)(lds + PG8_SB(b, h) + boff + n * 2048 + k * 1024); } while (0)
#define PG8_MMA(ai, bj, At, Bt) do { __builtin_amdgcn_s_setprio(1); _Pragma("unroll") for (int m = 0; m < 4; ++m) _Pragma("unroll") for (int n = 0; n < 2; ++n) _Pragma("unroll") for (int k = 0; k < 2; ++k) \
        acc[ai][bj][m][n] = __builtin_amdgcn_mfma_f32_16x16x32_bf16(Bt[n][k], At[m][k], acc[ai][bj][m][n], 0, 0, 0); __builtin_amdgcn_s_setprio(0); } while (0)
#define PG8_WAIT_V(n) asm volatile("s_waitcnt vmcnt(" #n ")" ::: "memory")
#define PG8_WAIT_L(n) asm volatile("s_waitcnt lgkmcnt(" #n ")" ::: "memory")
#define PG8_BAR __builtin_amdgcn_s_barrier()
#define PG8_SCHED __builtin_amdgcn_sched_barrier(0)
    Unit cur, nxt; int ui = 0;
    if (!S.next(0, cur)) return;
    f32x4 acc[2][2][4][2];
#pragma unroll
    for (int a = 0; a < 2; ++a)
#pragma unroll
        for (int b = 0; b < 2; ++b)
#pragma unroll
            for (int m = 0; m < 4; ++m)
#pragma unroll
                for (int n = 0; n < 2; ++n) acc[a][b][m][n] = (f32x4){0.f, 0.f, 0.f, 0.f};
    bf16x8 At[4][2], B0[2][2], B1[2][2];
    const char* cA = (const char*)g.A + (size_t)cur.pm * tstep; const char* cB = (const char*)g.Bt + (size_t)cur.pn * tstep;
    S.a_ready(cur);
    if constexpr (SP2) {
        PG8_STAGE(PG8_SB(0, 0), cB, voffB); PG8_STAGE(PG8_SB(0, 1), cB + hstep, voffB); PG8_STAGE(PG8_SA(0, 0), cA, voffA); PG8_STAGE(PG8_SA(0, 1), cA + hstep, voffA);
        if (wr == 1) PG8_BAR;
        PG8_WAIT_V(2); PG8_BAR;
        PG8_STAGE(PG8_SB(1, 0), cB + kstep, voffB); PG8_STAGE(PG8_SA(1, 0), cA + kstep, voffA); PG8_STAGE(PG8_SB(1, 1), cB + hstep + kstep, voffB);
        PG8_WAIT_V(6); PG8_BAR;
    } else {
        PG8_STAGE(PG8_SB(0, 0), cB, voffB); PG8_STAGE(PG8_SA(0, 0), cA, voffA); PG8_STAGE(PG8_SB(0, 1), cB + hstep, voffB); PG8_STAGE(PG8_SA(0, 1), cA + hstep, voffA);
        if (wr == 1) PG8_BAR;
        PG8_WAIT_V(4); PG8_BAR;
        PG8_STAGE(PG8_SB(1, 0), cB + kstep, voffB); PG8_STAGE(PG8_SA(1, 0), cA + kstep, voffA); PG8_STAGE(PG8_SB(1, 1), cB + hstep + kstep, voffB);
        PG8_WAIT_V(6); PG8_BAR;
    }
    for (;;) {
        const bool has_next = S.next(ui + 1, nxt);
        const char* nA = has_next ? (const char*)g.A + (size_t)nxt.pm * tstep : cA; const char* nB = has_next ? (const char*)g.Bt + (size_t)nxt.pn * tstep : cB;
        for (int t = 0; t < nt; t += 2) {
            const bool last = (t == nt - 2);
            const char* a1 = cA + (size_t)(t + 1) * kstep;
            const char* a2 = last ? nA : cA + (size_t)(t + 2) * kstep; const char* b2 = last ? nB : cB + (size_t)(t + 2) * kstep;
            const char* a3 = a2 + kstep; const char* b3 = b2 + kstep;
            if (last && has_next) S.a_ready(nxt);
            if constexpr (SP2) {
            PG8_LDB(B0, 0, 0); PG8_LDB(B1, 0, 1); PG8_SCHED; PG8_LDA(At, 0, 0); PG8_STAGE(PG8_SA(1, 1), a1 + hstep, voffA);
            PG8_WAIT_V(8); PG8_WAIT_L(0); PG8_BAR; PG8_MMA(0, 0, At, B0); PG8_MMA(0, 1, At, B1); PG8_BAR; PG8_SCHED;
            PG8_LDA(At, 0, 1); PG8_STAGE(PG8_SB(0, 0), b2, voffB); PG8_STAGE(PG8_SB(0, 1), b2 + hstep, voffB); PG8_STAGE(PG8_SA(0, 0), a2, voffA);
            PG8_WAIT_V(8); PG8_WAIT_L(0); PG8_BAR; PG8_MMA(1, 0, At, B0); PG8_MMA(1, 1, At, B1); PG8_BAR; PG8_SCHED;
            PG8_LDB(B0, 1, 0); PG8_LDB(B1, 1, 1); PG8_SCHED; PG8_LDA(At, 1, 0); PG8_STAGE(PG8_SA(0, 1), a2 + hstep, voffA);
            PG8_WAIT_V(8); PG8_WAIT_L(0); PG8_BAR; PG8_MMA(0, 0, At, B0); PG8_MMA(0, 1, At, B1); PG8_BAR; PG8_SCHED;
            PG8_LDA(At, 1, 1); PG8_STAGE(PG8_SB(1, 0), b3, voffB); PG8_STAGE(PG8_SB(1, 1), b3 + hstep, voffB); PG8_STAGE(PG8_SA(1, 0), a3, voffA);
            PG8_WAIT_V(8); PG8_WAIT_L(0); PG8_BAR; PG8_MMA(1, 0, At, B0); PG8_MMA(1, 1, At, B1); PG8_BAR; PG8_SCHED;
            } else {
            PG8_LDB(B0, 0, 0); PG8_SCHED; PG8_LDA(At, 0, 0); PG8_STAGE(PG8_SA(1, 1), a1 + hstep, voffA);
            PG8_WAIT_L(8); PG8_BAR; PG8_WAIT_L(0); PG8_MMA(0, 0, At, B0); PG8_BAR; PG8_SCHED;
            PG8_LDB(B1, 0, 1); PG8_STAGE(PG8_SB(0, 0), b2, voffB);
            PG8_BAR; PG8_WAIT_L(0); PG8_MMA(0, 1, At, B1); PG8_BAR;
            PG8_LDA(At, 0, 1); PG8_STAGE(PG8_SA(0, 0), a2, voffA);
            PG8_BAR; PG8_WAIT_L(0); PG8_MMA(1, 0, At, B0); PG8_BAR; PG8_SCHED;
            PG8_STAGE(PG8_SB(0, 1), b2 + hstep, voffB);
            PG8_WAIT_V(6); PG8_BAR; PG8_MMA(1, 1, At, B1); PG8_BAR;
            PG8_LDB(B0, 1, 0); PG8_SCHED; PG8_LDA(At, 1, 0); PG8_STAGE(PG8_SA(0, 1), a2 + hstep, voffA);
            PG8_WAIT_L(8); PG8_BAR; PG8_WAIT_L(0); PG8_MMA(0, 0, At, B0); PG8_BAR; PG8_SCHED;
            PG8_LDB(B1, 1, 1); PG8_STAGE(PG8_SB(1, 0), b3, voffB);
            PG8_BAR; PG8_WAIT_L(0); PG8_MMA(0, 1, At, B1); PG8_BAR;
            PG8_LDA(At, 1, 1); PG8_STAGE(PG8_SA(1, 0), a3, voffA);
            PG8_BAR; PG8_WAIT_L(0); PG8_MMA(1, 0, At, B0); PG8_BAR; PG8_SCHED;
            PG8_STAGE(PG8_SB(1, 1), b3 + hstep, voffB);
            PG8_WAIT_V(6); PG8_BAR; PG8_MMA(1, 1, At, B1); PG8_BAR;
            }
        }
        if constexpr (ALIGN_EPI) { if (wr == 0) PG8_BAR; }
        if constexpr (!Epi::AFTER_DRAIN) { E(acc, cur, wr, wc, fr, fq); S.done(cur); }
        if (!has_next) break;
        if (!E.keep(cur)) {
#pragma unroll
        for (int a = 0; a < 2; ++a)
#pragma unroll
            for (int b = 0; b < 2; ++b)
#pragma unroll
                for (int m = 0; m < 4; ++m)
#pragma unroll
                    for (int n = 0; n < 2; ++n) acc[a][b][m][n] = (f32x4){0.f, 0.f, 0.f, 0.f};
        }
        cur = nxt; cA = nA; cB = nB; ++ui;
        if constexpr (ALIGN_EPI) { if (wr == 1) PG8_BAR; }
    }
    PG8_WAIT_V(0);
    if constexpr (!ALIGN_EPI) { if (wr == 0) PG8_BAR; }
    PG8_BAR;
    if constexpr (Epi::AFTER_DRAIN) { E.fused(acc, cur, wr, wc, fr, fq, lds, wid, lane); S.done(cur); }
#undef PG8_SA
#undef PG8_SB
#undef PG8_STAGE
#undef PG8_LDA
#undef PG8_LDB
#undef PG8_MMA
#undef PG8_WAIT_V
#undef PG8_WAIT_L
#undef PG8_BAR
#undef PG8_SCHED
}
}

#ifndef PG8_SP2
#define PG8_SP2 true
#endif
#ifndef PG8_ALIGN
#define PG8_ALIGN true
#endif
namespace pg8 {
typedef unsigned u32x2 __attribute__((ext_vector_type(2)));
__device__ __forceinline__ unsigned cvtpk(float lo, float hi) { typedef float f2_ __attribute__((ext_vector_type(2))); typedef __bf16 b2_ __attribute__((ext_vector_type(2))); f2_ v = {lo, hi}; b2_ b = __builtin_convertvector(v, b2_); return __builtin_bit_cast(unsigned, b); }
__device__ __forceinline__ float bflo(unsigned u) { return __uint_as_float(u << 16); }
__device__ __forceinline__ float bfhi(unsigned u) { return __uint_as_float(u & 0xffff0000u); }
__device__ __forceinline__ float sigm_f(float x) { return __builtin_amdgcn_rcpf(1.0f + __builtin_amdgcn_exp2f(-1.4426950408889634f * x)); }
constexpr float Q_SCALE = 0.125f * 1.4426950408889634f;
constexpr float IDX_SCALE = 0.125f * 0.35355339059327373f;

__device__ __forceinline__ void prefetch_tile_bf16(const bf16_t* base, int ldc, int row0, int col0, PG8_LAS unsigned char* lds, int tid) {
    PG8_LAS unsigned* scrap = (PG8_LAS unsigned*)(lds + 135168 + (tid >> 6) * 256);
#pragma unroll
    for (int j = 0; j < 2; ++j) { const int li = tid + 512 * j; const bf16_t* p = base + (size_t)(row0 + (li >> 2)) * ldc + col0 + (li & 3) * 64;
        __builtin_amdgcn_global_load_lds((const unsigned*)p, scrap, 4, 0, 0); }
}
struct EpiP1 {
    static constexpr bool PERM = true, AFTER_DRAIN = false;
    __device__ __forceinline__ bool keep(const Unit&) const { return false; }
    __device__ __forceinline__ void prefetch(const Unit&, PG8_LAS unsigned char*, int) const {}
    const float* rs0; bf16_t *Q, *Kb, *V, *ZA, *QI, *U, *ZB, *GA, *GB, *KI; float* WI;
    __device__ __forceinline__ void operator()(const f32x4 (&acc)[2][2][4][2], const Unit& u, int wr, int wc, int fr, int fq) const {
        const int pn = u.pn; const int row0 = u.pm * BM + wr * 64 + fr;
        int type = 0; bf16_t* base = Q; int ld = 512, colt = 0; float sc = 1.f;
        if (pn < 10) { const int sec = pn >> 1; base = sec == 0 ? Q : sec == 1 ? Kb : sec == 2 ? V : sec == 3 ? ZA : QI; colt = (pn & 1) * 256; type = (sec == 3) ? 1 : 0; if (sec == 0) sc = Q_SCALE; }
        else if (pn < 14) { type = 3; base = U; colt = (pn - 10) * 128; }
        else if (pn < 16) { type = 1; base = ZB; colt = (pn - 14) * 256; }
        else if (pn < 20) { type = 2; base = GA; ld = 1024; colt = (pn - 16) * 256; }
        else if (pn < 24) { type = 2; base = GB; ld = 1024; colt = (pn - 20) * 256; }
        else type = 4;
        const int col0 = colt + wc * 32 + 8 * fq;
        float rsv[2][4];
#pragma unroll
        for (int ai = 0; ai < 2; ++ai)
#pragma unroll
            for (int m = 0; m < 4; ++m) rsv[ai][m] = rs0[row0 + ai * HALF + m * 16];
        asm volatile("" ::: "memory");
#pragma unroll
        for (int ai = 0; ai < 2; ++ai)
#pragma unroll
            for (int m = 0; m < 4; ++m) {
                const int row = row0 + ai * HALF + m * 16;
                const float r = rsv[ai][m] * sc;
                if (type <= 2) {
                    bf16_t* rowp = base + (size_t)row * ld + col0;
#pragma unroll
                    for (int bj = 0; bj < 2; ++bj) {
                        f32x4 v0 = acc[ai][bj][m][0] * r, v1 = acc[ai][bj][m][1] * r;
                        if (type == 1) {
#pragma unroll
                            for (int e = 0; e < 4; ++e) { v0[e] = v0[e] * sigm_f(v0[e]); v1[e] = v1[e] * sigm_f(v1[e]); }
                        } else if (type == 2) {
#pragma unroll
                            for (int e = 0; e < 4; ++e) { v0[e] = sigm_f(v0[e]); v1[e] = sigm_f(v1[e]); }
                        }
                        u32x4 w; w.x = cvtpk(v0[0], v0[1]); w.y = cvtpk(v0[2], v0[3]); w.z = cvtpk(v1[0], v1[1]); w.w = cvtpk(v1[2], v1[3]);
                        if (type == 2) __builtin_nontemporal_store(w, (u32x4*)(rowp + bj * HALF));
                        else *(u32x4*)(rowp + bj * HALF) = w;
                    }
                } else if (type == 3) {
                    f32x4 a0 = acc[ai][0][m][0] * r, a1 = acc[ai][0][m][1] * r, b0 = acc[ai][1][m][0] * r, b1 = acc[ai][1][m][1] * r;
#pragma unroll
                    for (int e = 0; e < 4; ++e) { a0[e] = a0[e] * sigm_f(b0[e]); a1[e] = a1[e] * sigm_f(b1[e]); }
                    u32x4 w; w.x = cvtpk(a0[0], a0[1]); w.y = cvtpk(a0[2], a0[3]); w.z = cvtpk(a1[0], a1[1]); w.w = cvtpk(a1[2], a1[3]);
                    *(u32x4*)(base + (size_t)row * 512 + col0) = w;
                } else {
                    if (wc < 2) {
                        const f32x4 v0 = acc[ai][0][m][0] * r, v1 = acc[ai][0][m][1] * r;
                        u32x4 w; w.x = cvtpk(v0[0], v0[1]); w.y = cvtpk(v0[2], v0[3]); w.z = cvtpk(v1[0], v1[1]); w.w = cvtpk(v1[2], v1[3]);
                        const int c0 = wc * 32 + 8 * fq;
                        *(u32x4*)(KI + (size_t)(row >> 5) * 2048 + (((c0 >> 4) * 2 + ((c0 >> 3) & 1)) * 32 + (row & 31)) * 8) = w;
                    } else if (wc == 2 && fq == 0) {
                        const float rr = r * IDX_SCALE;
                        *(f32x4*)(WI + (size_t)row * 8) = acc[ai][0][m][0] * rr;
                        *(f32x4*)(WI + (size_t)row * 8 + 4) = acc[ai][0][m][1] * rr;
                    }
                }
            }
    }
};

template <bool ADD> struct EpiGate {
    static constexpr bool PERM = true, AFTER_DRAIN = false;
    __device__ __forceinline__ bool keep(const Unit&) const { return false; }
    __device__ __forceinline__ void prefetch(const Unit&, PG8_LAS unsigned char*, int) const {}
    const bf16_t* G; bf16_t* O; int ldc;
    __device__ __forceinline__ void operator()(const f32x4 (&acc)[2][2][4][2], const Unit& u, int wr, int wc, int fr, int fq) const {
        const int row0 = u.pm * BM + wr * 64 + fr, col0 = u.pn * BM + wc * 32 + 8 * fq;
#pragma unroll
        for (int ai = 0; ai < 2; ++ai) {
            u32x4 gv[4][2], ov[4][2];
#pragma unroll
            for (int m = 0; m < 4; ++m)
#pragma unroll
                for (int bj = 0; bj < 2; ++bj) { const size_t off = (size_t)(row0 + ai * HALF + m * 16) * ldc + col0 + bj * HALF; gv[m][bj] = *(const u32x4*)(G + off); if (ADD) ov[m][bj] = *(const u32x4*)(O + off); }
            asm volatile("" ::: "memory");
#pragma unroll
            for (int m = 0; m < 4; ++m)
#pragma unroll
                for (int bj = 0; bj < 2; ++bj) {
                    const size_t off = (size_t)(row0 + ai * HALF + m * 16) * ldc + col0 + bj * HALF; const u32x4 g = gv[m][bj];
                    f32x4 v0 = acc[ai][bj][m][0], v1 = acc[ai][bj][m][1];
                    v0[0] *= bflo(g.x); v0[1] *= bfhi(g.x); v0[2] *= bflo(g.y); v0[3] *= bfhi(g.y); v1[0] *= bflo(g.z); v1[1] *= bfhi(g.z); v1[2] *= bflo(g.w); v1[3] *= bfhi(g.w);
                    if (ADD) { const u32x4 o = ov[m][bj];
                        v0[0] += bflo(o.x); v0[1] += bfhi(o.x); v0[2] += bflo(o.y); v0[3] += bfhi(o.y); v1[0] += bflo(o.z); v1[1] += bfhi(o.z); v1[2] += bflo(o.w); v1[3] += bfhi(o.w); }
                    u32x4 w; w.x = cvtpk(v0[0], v0[1]); w.y = cvtpk(v0[2], v0[3]); w.z = cvtpk(v1[0], v1[1]); w.w = cvtpk(v1[2], v1[3]);
                    *(u32x4*)(O + off) = w;
                }
            asm volatile("" ::: "memory");
        }
    }
};

struct PairOrder {
    StaticOrder so; int dpm, dpn;
    __device__ bool next(int i, Unit& u) const { Unit b; if (!so.next(i >> 1, b)) return false; u.pm = b.pm + ((i & 1) ? dpm : 0); u.pn = b.pn + ((i & 1) ? dpn : 0); return true; }
    __device__ __forceinline__ void a_ready(const Unit&) const {}
    __device__ __forceinline__ void done(const Unit&) const {}
};
struct EpiBranch {
    static constexpr bool PERM = true, AFTER_DRAIN = false;
    const bf16_t* GA; const bf16_t* GB; bf16_t* O; int ldc, dpm, dpn;
    __device__ __forceinline__ bool keep(const Unit& u) const { return u.pm < dpm; }
    __device__ __forceinline__ void prefetch(const Unit& u, PG8_LAS unsigned char* lds, int tid) const { if (u.pm < dpm) { prefetch_tile_bf16(GA, ldc, u.pm * BM, u.pn * BM, lds, tid); prefetch_tile_bf16(GB, ldc, u.pm * BM, u.pn * BM, lds, tid); } }
    __device__ __forceinline__ void operator()(f32x4 (&acc)[2][2][4][2], const Unit& u, int wr, int wc, int fr, int fq) const {
        const bool second = u.pm >= dpm; const int pm = second ? u.pm - dpm : u.pm, pn = second ? u.pn - dpn : u.pn;
        const int row0 = pm * BM + wr * 64 + fr, col0 = pn * BM + wc * 32 + 8 * fq;
#pragma unroll
        for (int ai = 0; ai < 2; ++ai) {
            u32x4 gb[4][2], ga[4][2];
#pragma unroll
            for (int m = 0; m < 4; ++m)
#pragma unroll
                for (int bj = 0; bj < 2; ++bj) { const size_t off = (size_t)(row0 + ai * HALF + m * 16) * ldc + col0 + bj * HALF; gb[m][bj] = second ? __builtin_nontemporal_load((const u32x4*)(GB + off)) : *(const u32x4*)(GB + off); if (!second) ga[m][bj] = __builtin_nontemporal_load((const u32x4*)(GA + off)); }
            asm volatile("" ::: "memory");
#pragma unroll
            for (int m = 0; m < 4; ++m)
#pragma unroll
                for (int bj = 0; bj < 2; ++bj) {
                    const u32x4 b = gb[m][bj];
                    if (!second) {
                        const u32x4 a = ga[m][bj];
                        acc[ai][bj][m][0][0] *= bflo(a.x) * __builtin_amdgcn_rcpf(bflo(b.x)); acc[ai][bj][m][0][1] *= bfhi(a.x) * __builtin_amdgcn_rcpf(bfhi(b.x));
                        acc[ai][bj][m][0][2] *= bflo(a.y) * __builtin_amdgcn_rcpf(bflo(b.y)); acc[ai][bj][m][0][3] *= bfhi(a.y) * __builtin_amdgcn_rcpf(bfhi(b.y));
                        acc[ai][bj][m][1][0] *= bflo(a.z) * __builtin_amdgcn_rcpf(bflo(b.z)); acc[ai][bj][m][1][1] *= bfhi(a.z) * __builtin_amdgcn_rcpf(bfhi(b.z));
                        acc[ai][bj][m][1][2] *= bflo(a.w) * __builtin_amdgcn_rcpf(bflo(b.w)); acc[ai][bj][m][1][3] *= bfhi(a.w) * __builtin_amdgcn_rcpf(bfhi(b.w));
                    } else {
                        const f32x4 v0 = acc[ai][bj][m][0], v1 = acc[ai][bj][m][1];
                        u32x4 w; w.x = cvtpk(v0[0] * bflo(b.x), v0[1] * bfhi(b.x)); w.y = cvtpk(v0[2] * bflo(b.y), v0[3] * bfhi(b.y)); w.z = cvtpk(v1[0] * bflo(b.z), v1[1] * bfhi(b.z)); w.w = cvtpk(v1[2] * bflo(b.w), v1[3] * bfhi(b.w));
                        *(u32x4*)(O + (size_t)(row0 + ai * HALF + m * 16) * ldc + col0 + bj * HALF) = w;
                    }
                }
            asm volatile("" ::: "memory");
        }
    }
};

struct EpiPlain {
    static constexpr bool PERM = true, AFTER_DRAIN = false;
    __device__ __forceinline__ bool keep(const Unit&) const { return false; }
    __device__ __forceinline__ void prefetch(const Unit&, PG8_LAS unsigned char*, int) const {}
    bf16_t* O; int ldc;
    __device__ __forceinline__ void operator()(const f32x4 (&acc)[2][2][4][2], const Unit& u, int wr, int wc, int fr, int fq) const {
        const int row0 = u.pm * BM + wr * 64 + fr, col0 = u.pn * BM + wc * 32 + 8 * fq;
#pragma unroll
        for (int ai = 0; ai < 2; ++ai)
#pragma unroll
            for (int m = 0; m < 4; ++m) {
                bf16_t* rowp = O + (size_t)(row0 + ai * HALF + m * 16) * ldc + col0;
#pragma unroll
                for (int bj = 0; bj < 2; ++bj) {
                    const f32x4 v0 = acc[ai][bj][m][0], v1 = acc[ai][bj][m][1];
                    u32x4 w; w.x = cvtpk(v0[0], v0[1]); w.y = cvtpk(v0[2], v0[3]); w.z = cvtpk(v1[0], v1[1]); w.w = cvtpk(v1[2], v1[3]);
                    *(u32x4*)(rowp + bj * HALF) = w;
                }
            }
    }
};

struct EpiX1 {
    static constexpr bool PERM = true, AFTER_DRAIN = false;
    __device__ __forceinline__ bool keep(const Unit&) const { return false; }
    __device__ __forceinline__ void prefetch(const Unit& u, PG8_LAS unsigned char* lds, int tid) const { prefetch_tile_bf16(xin, ldc, u.pm * BM, u.pn * BM, lds, tid); }
    const bf16_t* xin; bf16_t* x1b; float* rss; int ldc;
    __device__ __forceinline__ void operator()(const f32x4 (&acc)[2][2][4][2], const Unit& u, int wr, int wc, int fr, int fq) const {
        const int row0 = u.pm * BM + wr * 64 + fr, col0 = u.pn * BM + wc * 32 + 8 * fq;
#pragma unroll
        for (int ai = 0; ai < 2; ++ai) {
            u32x4 xv[4][2];
#pragma unroll
            for (int m = 0; m < 4; ++m)
#pragma unroll
                for (int bj = 0; bj < 2; ++bj) xv[m][bj] = *(const u32x4*)(xin + (size_t)(row0 + ai * HALF + m * 16) * ldc + col0 + bj * HALF);
            asm volatile("" ::: "memory");
#pragma unroll
            for (int m = 0; m < 4; ++m) {
                const int row = row0 + ai * HALF + m * 16; const size_t off = (size_t)row * ldc + col0; float s = 0.f;
#pragma unroll
                for (int bj = 0; bj < 2; ++bj) {
                    const u32x4 xi = xv[m][bj];
                    f32x4 v0 = acc[ai][bj][m][0], v1 = acc[ai][bj][m][1];
                    v0[0] += bflo(xi.x); v0[1] += bfhi(xi.x); v0[2] += bflo(xi.y); v0[3] += bfhi(xi.y); v1[0] += bflo(xi.z); v1[1] += bfhi(xi.z); v1[2] += bflo(xi.w); v1[3] += bfhi(xi.w);
                    s += ((v0[0] * v0[0] + v0[1] * v0[1]) + (v0[2] * v0[2] + v0[3] * v0[3])) + ((v1[0] * v1[0] + v1[1] * v1[1]) + (v1[2] * v1[2] + v1[3] * v1[3]));
                    u32x4 w; w.x = cvtpk(v0[0], v0[1]); w.y = cvtpk(v0[2], v0[3]); w.z = cvtpk(v1[0], v1[1]); w.w = cvtpk(v1[2], v1[3]);
                    *(u32x4*)(x1b + off + bj * HALF) = w;
                }
                s += __shfl_xor(s, 16); s += __shfl_xor(s, 32);
                if (fq == 0) atomicAdd(rss + row, s);
            }
            asm volatile("" ::: "memory");
        }
    }
};

struct EpiX2 {
    static constexpr bool PERM = true, AFTER_DRAIN = false;
    __device__ __forceinline__ bool keep(const Unit&) const { return false; }
    __device__ __forceinline__ void prefetch(const Unit& u, PG8_LAS unsigned char* lds, int tid) const { prefetch_tile_bf16(this->e, ldc, u.pm * BM, u.pn * BM, lds, tid); }
    const bf16_t* x1b; const bf16_t* e; bf16_t* x2b; const float* rss1; float* rss2; int ldc; float eps;
    __device__ __forceinline__ void operator()(const f32x4 (&acc)[2][2][4][2], const Unit& u, int wr, int wc, int fr, int fq) const {
        const int row0 = u.pm * BM + wr * 64 + fr, col0 = u.pn * BM + wc * 32 + 8 * fq;
#pragma unroll
        for (int ai = 0; ai < 2; ++ai) {
            u32x4 xv[4][2], ev[4][2]; float rv[4];
#pragma unroll
            for (int m = 0; m < 4; ++m) { rv[m] = rss1[row0 + ai * HALF + m * 16];
#pragma unroll
                for (int bj = 0; bj < 2; ++bj) { const size_t off = (size_t)(row0 + ai * HALF + m * 16) * ldc + col0 + bj * HALF; xv[m][bj] = *(const u32x4*)(x1b + off); ev[m][bj] = *(const u32x4*)(e + off); } }
            asm volatile("" ::: "memory");
#pragma unroll
            for (int m = 0; m < 4; ++m) {
                const int row = row0 + ai * HALF + m * 16; const size_t off = (size_t)row * ldc + col0; float s = 0.f;
                const float rstd = 1.0f / sqrtf(rv[m] * (1.0f / 1024.0f) + eps);
#pragma unroll
                for (int bj = 0; bj < 2; ++bj) {
                    const u32x4 xi = xv[m][bj], ei = ev[m][bj];
                    const f32x4 a0 = acc[ai][bj][m][0] * rstd, a1 = acc[ai][bj][m][1] * rstd; f32x4 v0, v1;
                    v0[0] = bflo(xi.x) + sigm_f(a0[0]) * bflo(ei.x); v0[1] = bfhi(xi.x) + sigm_f(a0[1]) * bfhi(ei.x); v0[2] = bflo(xi.y) + sigm_f(a0[2]) * bflo(ei.y); v0[3] = bfhi(xi.y) + sigm_f(a0[3]) * bfhi(ei.y);
                    v1[0] = bflo(xi.z) + sigm_f(a1[0]) * bflo(ei.z); v1[1] = bfhi(xi.z) + sigm_f(a1[1]) * bfhi(ei.z); v1[2] = bflo(xi.w) + sigm_f(a1[2]) * bflo(ei.w); v1[3] = bfhi(xi.w) + sigm_f(a1[3]) * bfhi(ei.w);
                    s += ((v0[0] * v0[0] + v0[1] * v0[1]) + (v0[2] * v0[2] + v0[3] * v0[3])) + ((v1[0] * v1[0] + v1[1] * v1[1]) + (v1[2] * v1[2] + v1[3] * v1[3]));
                    u32x4 w; w.x = cvtpk(v0[0], v0[1]); w.y = cvtpk(v0[2], v0[3]); w.z = cvtpk(v1[0], v1[1]); w.w = cvtpk(v1[2], v1[3]);
                    *(u32x4*)(x2b + off + bj * HALF) = w;
                }
                s += __shfl_xor(s, 16); s += __shfl_xor(s, 32);
                if (fq == 0) atomicAdd(rss2 + row, s);
            }
            asm volatile("" ::: "memory");
        }
    }
};
}
constexpr int NWAVES = 8;
#ifndef MK_N_LAUNCHES
#define MK_N_LAUNCHES 1
#endif
constexpr int N_PHASES = 8;
constexpr int N_LAUNCHES = MK_N_LAUNCHES;

constexpr int BATCH = 8, SEQ = 4096, DM = 1024, M = BATCH * SEQ, AW = 512, NH = 8, HD = 64, PLE = 256, NWIN = 6216, NWP = 6400, CK = 31, TOPK = 256;
constexpr int O_Q = 0, O_KI = 2560, O_WI = 2624, O_GLU = 2632, O_ZB = 3656, O_GA = 4168, O_GB = 5192;
constexpr float EPS = 1e-6f;
constexpr int BT_STRIDE = 160;

constexpr size_t MiB = 1u << 20;
constexpr size_t WS_CTL = 0, CTL_ZERO_BYTES = 1 * MiB;
constexpr size_t WS_RS1 = 512 * 1024, WS_RS2 = 768 * 1024;
constexpr size_t WS_WIN = 2 * MiB;
constexpr size_t WS_WBA = 15 * MiB, WS_WBB = 16 * MiB, WS_WOUT = 17 * MiB, WS_WPG = 19 * MiB, WS_WPP = 21 * MiB;
constexpr size_t WS_BIAS = 21 * MiB + 512 * 1024;
constexpr size_t WS_RS0 = 22 * MiB;
constexpr size_t WS_WI = 23 * MiB;
constexpr size_t WS_KI = 24 * MiB;
constexpr size_t WS_MASK = 28 * MiB;
constexpr size_t WS_PB = 44 * MiB;
constexpr size_t WS_XB = 64 * MiB;
constexpr size_t WS_Q = 128 * MiB, WS_K = 160 * MiB, WS_V = 192 * MiB, WS_ZA = 224 * MiB, WS_QI = 256 * MiB, WS_U = 288 * MiB, WS_ZB = 320 * MiB;
constexpr size_t WS_GA = 352 * MiB, WS_GB = 416 * MiB, WS_END = 480 * MiB;
constexpr int CW_BAR = 4096;

constexpr int RING_BYTES = 131072;
constexpr int LDSCTL_OFF = RING_BYTES, MISC_OFF = LDSCTL_OFF + 320;
constexpr int LDS_BYTES = 161792;

#define GAS __attribute__((address_space(1)))
#define LAS __attribute__((address_space(3)))
typedef unsigned short bf16;
typedef unsigned v4u __attribute__((ext_vector_type(4)));
typedef float f32x4 __attribute__((ext_vector_type(4)));
typedef short bf16x8 __attribute__((ext_vector_type(8)));
typedef GAS unsigned gu32;
typedef GAS unsigned long long gu64;
#define RLX_AGENT __ATOMIC_RELAXED, __HIP_MEMORY_SCOPE_AGENT
#define LDS_WAIT() asm volatile("s_waitcnt lgkmcnt(0)" ::: "memory")
#define VM_WAIT() asm volatile("s_waitcnt vmcnt(0)" ::: "memory")
__device__ __forceinline__ unsigned long long rt() { return __builtin_amdgcn_s_memrealtime(); }
__device__ __forceinline__ unsigned f2bf(float f) { unsigned u = __builtin_bit_cast(unsigned, f); return (u + 0x7fffu + ((u >> 16) & 1u)) >> 16; }
__device__ __forceinline__ unsigned pk2(float lo, float hi) { return f2bf(lo) | (f2bf(hi) << 16); }

#define XB_TMO      128
#define XB_XCNT(j)  (256  + 64 * (j))
#define XB_XSUB(j)  (1280 + 64 * (j))
#define XB_XGEN(j)  (2304 + 64 * (j))
#define XB_TOP      3328
#define XB_TOPGEN   3392
#define XCD_BAR_WORDS 3456
#define XB_SPIN_CAP (1u << 18)

__device__ __forceinline__ unsigned xb_ld(unsigned* p)              { return __hip_atomic_load(p, __ATOMIC_RELAXED, __HIP_MEMORY_SCOPE_AGENT); }
__device__ __forceinline__ unsigned xb_add(unsigned* p, unsigned v) { return __hip_atomic_fetch_add(p, v, __ATOMIC_RELAXED, __HIP_MEMORY_SCOPE_AGENT); }
__device__ __forceinline__ unsigned xb_xcc_id() { return (unsigned)__builtin_amdgcn_s_getreg((3 << 11) | 20) & 0xFu; }
#define XB_SPIN(cond, bar) do { unsigned _sp = 0; while (cond) { __builtin_amdgcn_s_sleep(1); \
    if ((++_sp & 255u) == 0u) { if (xb_ld(&(bar)[XB_TMO])) break; if (_sp > XB_SPIN_CAP) { atomicAdd(&(bar)[XB_TMO], 1u); break; } } } } while (0)

struct XcdBarrier {
    unsigned* bar; unsigned x;
    volatile LAS unsigned* st;
};

__device__ __forceinline__ XcdBarrier xcd_barrier_post(unsigned* bar, volatile LAS unsigned* st) {
    XcdBarrier b; b.bar = bar; b.x = xb_xcc_id(); b.st = st;
    if (threadIdx.x == 0) (void)xb_add(&bar[XB_XCNT(b.x)], 1u);
    return b;
}
__device__ __forceinline__ void xcd_barrier_complete(unsigned* bar, unsigned x, unsigned& nloc, unsigned& nx) {
    const unsigned G = gridDim.x * gridDim.y * gridDim.z;
    unsigned sum, cnt, mine, sp = 0u;
    for (;;) {
        sum = 0u; cnt = 0u; mine = 0u;
#pragma unroll
        for (unsigned j = 0; j < 16; ++j) { const unsigned c = xb_ld(&bar[XB_XCNT(j)]); sum += c; cnt += (c > 0u) ? 1u : 0u; mine = (j == x) ? c : mine; }
        if (sum == G) break;
        __builtin_amdgcn_s_sleep(1);
        if ((++sp & 255u) == 0u) { if (xb_ld(&bar[XB_TMO])) break; if (sp > XB_SPIN_CAP) { atomicAdd(&bar[XB_TMO], 1u); break; } }
    }
    nloc = mine > 0u ? mine : 1u; nx = cnt > 0u ? cnt : 1u;
}

__device__ __forceinline__ void xcd_barrier(const XcdBarrier& b) {
    asm volatile("s_waitcnt vmcnt(0)" ::: "memory");
    __syncthreads();
    if (threadIdx.x == 0) {
        unsigned* bar = b.bar;
        __builtin_amdgcn_s_waitcnt(0);
        unsigned nloc = b.st[0], nx = b.st[1];
        if (nloc == 0u) { xcd_barrier_complete(bar, b.x, nloc, nx); b.st[0] = nloc; b.st[1] = nx; }
        const unsigned old = xb_add(&bar[XB_XSUB(b.x)], 1u);
        const unsigned gen = old / nloc;
        if (old + 1u == (gen + 1u) * nloc) {
            __builtin_amdgcn_fence(__ATOMIC_RELEASE, "agent");
            asm volatile("s_waitcnt vmcnt(0)" ::: "memory");
            const unsigned og = xb_add(&bar[XB_TOP], 1u);
            const unsigned tg = og / nx;
            if (og + 1u == (tg + 1u) * nx) xb_add(&bar[XB_TOPGEN], 1u);
            else XB_SPIN(xb_ld(&bar[XB_TOPGEN]) == tg, bar);
            __builtin_amdgcn_fence(__ATOMIC_ACQUIRE, "agent");
            xb_add(&bar[XB_XGEN(b.x)], 1u);
            asm volatile("s_waitcnt vmcnt(0)" ::: "memory");
        } else {
            XB_SPIN(xb_ld(&bar[XB_XGEN(b.x)]) == gen, bar);
            __builtin_amdgcn_fence(__ATOMIC_ACQUIRE, "agent");
            asm volatile("s_waitcnt vmcnt(0)" ::: "memory");
        }
    }
    __syncthreads();
}
struct Args {
    const float *x, *p, *norm_in_g, *w_in, *conv_w, *conv_b, *conv_ln_g, *conv_ln_b, *w_ba, *w_bb, *w_out, *ple_g, *w_pg, *w_pp, *rel_bias, *fin_g;
    float* out; unsigned char* ws; int ph_lo, ph_hi;
};
typedef float f32x16 __attribute__((ext_vector_type(16)));
typedef unsigned u32x2 __attribute__((ext_vector_type(2)));
__device__ __forceinline__ unsigned cvtpk2(float lo, float hi) { return pg8::cvtpk(lo, hi); }
__device__ __forceinline__ float bf2f(unsigned short h) { return __uint_as_float(((unsigned)h) << 16); }
__device__ __forceinline__ float wave_sum(float v) {
#pragma unroll
    for (int o = 1; o < 64; o <<= 1) v += __shfl_xor(v, o);
    return v;
}
__device__ __forceinline__ int t5_bucket(int rel) {
    const int base = rel > 0 ? 16 : 0; const int n = rel < 0 ? -rel : rel; int v;
    if (n < 8) v = n; else if (n < 12) v = 8; else if (n < 16) v = 9; else if (n < 23) v = 10; else if (n < 32) v = 11; else if (n < 46) v = 12; else if (n < 64) v = 13; else if (n < 91) v = 14; else v = 15;
    return base + v;
}
__device__ __forceinline__ unsigned mono_key(float f) { const unsigned u = __float_as_uint(f); return u ^ ((unsigned)((int)u >> 31) | 0x80000000u); }
__device__ __forceinline__ float relu_i(float x) { const int b = (int)__float_as_uint(x); return __uint_as_float((unsigned)(b > 0 ? b : 0)); }
__device__ __forceinline__ float unmono_key(unsigned k) { return __uint_as_float((k & 0x80000000u) ? (k & 0x7fffffffu) : ~k); }

__device__ __forceinline__ void p0_item(const float* W, int K, int Nsrc, int scol0, int nvalid, const float* g, bf16* WT, int drow0, int k0, LAS float* scr, int lane) {
    const int j = lane & 31, jv = j < nvalid ? j : 0; const float msk = j < nvalid ? 1.f : 0.f;
    const float* wp = W + (size_t)(k0 + (lane >> 5)) * Nsrc + scol0 + jv;
    float v[32];
#pragma unroll
    for (int i = 0; i < 32; ++i) v[i] = wp[(size_t)(2 * i) * Nsrc];
    const int c = lane & 7;
    f32x4 g0 = {1.f, 1.f, 1.f, 1.f}, g1 = g0;
    if (g) { g0 = *(const GAS f32x4*)(g + k0 + 8 * c); g1 = *(const GAS f32x4*)(g + k0 + 8 * c + 4); }
#pragma unroll
    for (int i = 0; i < 32; ++i) scr[(2 * i + (lane >> 5)) * 33 + j] = v[i] * msk;
    LDS_WAIT(); asm volatile("" ::: "memory");
#pragma unroll
    for (int jj = 0; jj < 4; ++jj) { const int n = (lane >> 3) + 8 * jj; const LAS float* s = scr + (8 * c) * 33 + n;
        v4u o; o.x = pk2(s[0 * 33] * g0[0], s[1 * 33] * g0[1]); o.y = pk2(s[2 * 33] * g0[2], s[3 * 33] * g0[3]); o.z = pk2(s[4 * 33] * g1[0], s[5 * 33] * g1[1]); o.w = pk2(s[6 * 33] * g1[2], s[7 * 33] * g1[3]);
        *(GAS v4u*)(WT + (size_t)(drow0 + n) * K + k0 + 8 * c) = o; }
    LDS_WAIT(); asm volatile("" ::: "memory");
}
__device__ __forceinline__ void win_block(int db, int& scol0, int& nvalid) {
    const int pn = db >> 3, sub = db & 7; nvalid = 32;
    if (pn < 10) scol0 = pn * 256 + sub * 32;
    else if (pn < 14) scol0 = O_GLU + (pn - 10) * 128 + (sub < 4 ? sub * 32 : 512 + (sub - 4) * 32);
    else if (pn < 16) scol0 = O_ZB + (pn - 14) * 256 + sub * 32;
    else if (pn < 20) scol0 = O_GA + (pn - 16) * 256 + sub * 32;
    else if (pn < 24) scol0 = O_GB + (pn - 20) * 256 + sub * 32;
    else { if (sub < 2) scol0 = O_KI + sub * 32; else if (sub == 2) { scol0 = O_WI; nvalid = 8; } else { scol0 = 0; nvalid = 0; } }
}
__device__ __forceinline__ void p0_prologue(const Args& A, LAS unsigned char* lds, int vcu, int G) {
    const int tid = threadIdx.x, lane = tid & 63, wave = __builtin_amdgcn_readfirstlane(tid >> 6);
    unsigned char* ws = A.ws;
    LAS float* scr = (LAS float*)(lds + wave * 16384);
    const bool itemw = wave >= 4;
    const int gw = itemw ? vcu * 4 + (wave - 4) : vcu * 4 + wave, NGW = G * 4;
    constexpr int I_IN = 200 * 16, I_BA = 32 * 8, I_BB = 32 * 8, I_OUT = 32 * 16, I_PG = 32 * 16, I_PP = 32 * 4;
    constexpr int NITEMS = I_IN + I_BA + I_BB + I_OUT + I_PG + I_PP;
    if (itemw) for (int it = gw; it < NITEMS; it += NGW) {
        int r = it; const float* W; const float* gsc = nullptr; bf16* WT; int K, Nsrc, sc0, nv = 32, drow0, k0;
        if (r < I_IN) { const int db = r >> 4; win_block(db, sc0, nv); W = A.w_in; K = DM; Nsrc = NWIN; gsc = A.norm_in_g; WT = (bf16*)(ws + WS_WIN); drow0 = db * 32; k0 = (r & 15) * 64; }
        else if ((r -= I_IN) < I_BA) { W = A.w_ba; K = AW; Nsrc = DM; sc0 = (r >> 3) * 32; WT = (bf16*)(ws + WS_WBA); drow0 = sc0; k0 = (r & 7) * 64; }
        else if ((r -= I_BA) < I_BB) { W = A.w_bb; K = AW; Nsrc = DM; sc0 = (r >> 3) * 32; WT = (bf16*)(ws + WS_WBB); drow0 = sc0; k0 = (r & 7) * 64; }
        else if ((r -= I_BB) < I_OUT) { W = A.w_out; K = DM; Nsrc = DM; sc0 = (r >> 4) * 32; WT = (bf16*)(ws + WS_WOUT); drow0 = sc0; k0 = (r & 15) * 64; }
        else if ((r -= I_OUT) < I_PG) { W = A.w_pg; K = DM; Nsrc = DM; sc0 = (r >> 4) * 32; gsc = A.ple_g; WT = (bf16*)(ws + WS_WPG); drow0 = sc0; k0 = (r & 15) * 64; }
        else { r -= I_PG; W = A.w_pp; K = PLE; Nsrc = DM; sc0 = (r >> 2) * 32; WT = (bf16*)(ws + WS_WPP); drow0 = sc0; k0 = (r & 3) * 64; }
        p0_item(W, K, Nsrc, sc0, nv, gsc, WT, drow0, k0, scr, lane);
    }
#ifdef MK_PROBE_A
    if (blockIdx.x == 0 && tid == 0) ((unsigned long long*)(ws + WS_CTL + 256 * 1024))[30] = rt();
#endif
    bf16* XB = (bf16*)(ws + WS_XB); float* RS0 = (float*)(ws + WS_RS0); bf16* PB = (bf16*)(ws + WS_PB);
    if (!itemw) for (int m0 = gw * 4; m0 < M; m0 += NGW * 4) {
        f32x4 v[4][4], pv[4]; float s[4];
#pragma unroll
        for (int r = 0; r < 4; ++r) { const GAS f32x4* xr = (const GAS f32x4*)(A.x + (size_t)(m0 + r) * DM) + lane;
#pragma unroll
            for (int j = 0; j < 4; ++j) v[r][j] = __builtin_nontemporal_load(xr + 64 * j);
            pv[r] = __builtin_nontemporal_load((const GAS f32x4*)(A.p + (size_t)(m0 + r) * PLE) + lane); }
#pragma unroll
        for (int r = 0; r < 4; ++r) { float t = 0.f;
#pragma unroll
            for (int j = 0; j < 4; ++j) t += (v[r][j].x * v[r][j].x + v[r][j].y * v[r][j].y) + (v[r][j].z * v[r][j].z + v[r][j].w * v[r][j].w);
            s[r] = t; }
#pragma unroll
        for (int o = 1; o < 64; o <<= 1) {
#pragma unroll
            for (int r = 0; r < 4; ++r) s[r] += __shfl_xor(s[r], o); }
#pragma unroll
        for (int r = 0; r < 4; ++r) {
            if (lane == 0) RS0[m0 + r] = 1.0f / sqrtf(s[r] * (1.0f / DM) + EPS);
            GAS u32x2* o8 = (GAS u32x2*)(XB + (size_t)(m0 + r) * DM) + lane;
#pragma unroll
            for (int j = 0; j < 4; ++j) { u32x2 w; w.x = cvtpk2(v[r][j].x, v[r][j].y); w.y = cvtpk2(v[r][j].z, v[r][j].w); o8[64 * j] = w; }
            u32x2 w; w.x = cvtpk2(pv[r].x, pv[r].y); w.y = cvtpk2(pv[r].z, pv[r].w);
            ((GAS u32x2*)(PB + (size_t)(m0 + r) * PLE))[lane] = w;
        }
    }
#ifdef MK_PROBE_A
    if (blockIdx.x == 0 && tid == 0) ((unsigned long long*)(ws + WS_CTL + 256 * 1024))[31] = rt();
#endif
    if (vcu == 0) {
        float* BTg = (float*)(ws + WS_BIAS);
        for (int i = tid; i < NH * BT_STRIDE; i += NWAVES * 64) { const int h = i / BT_STRIDE, k = i % BT_STRIDE; const int rel = k - 91; const int bk = t5_bucket(rel < 64 ? rel : 63);
            BTg[i] = (A.rel_bias[bk * NH + h] - A.rel_bias[15 * NH + h]) * 1.4426950408889634f; }
    }
}

__device__ __forceinline__ void conv_phase(const Args& A, LAS unsigned char* lds, int vcu, int G) {
    const int tid = threadIdx.x, lane = tid & 63, wave = __builtin_amdgcn_readfirstlane(tid >> 6);
    const bf16* U = (const bf16*)(A.ws + WS_U); bf16* ZB = (bf16*)(A.ws + WS_ZB);
    LAS float* Y = (LAS float*)(lds + 65536);
    const int c = tid;
    float w[CK];
#pragma unroll
    for (int j = 0; j < CK; ++j) w[j] = A.conv_w[j * 512 + c];
    const float cb = A.conv_b[c];
    f32x4 lg0 = *(const GAS f32x4*)(A.conv_ln_g + 8 * lane), lg1 = *(const GAS f32x4*)(A.conv_ln_g + 8 * lane + 4);
    f32x4 lb0 = *(const GAS f32x4*)(A.conv_ln_b + 8 * lane), lb1 = *(const GAS f32x4*)(A.conv_ln_b + 8 * lane + 4);
    for (int tile = vcu; tile < M / 32; tile += G) {
        const int t0 = tile * 32, pos0 = t0 & (SEQ - 1);
        {
            v4u uv[8];
#pragma unroll
            for (int i = 0; i < 8; ++i) { const int id = tid + 512 * i, row = id >> 6, ch = id & 63; const int rr = (pos0 - 30 + row >= 0 && id < 62 * 64) ? row : 30;
                uv[i] = *(const GAS v4u*)(U + (size_t)(t0 - 30 + rr) * 512 + ch * 8); }
#pragma unroll
            for (int i = 0; i < 8; ++i) { const int id = tid + 512 * i, row = id >> 6, ch = id & 63;
                if (id < 62 * 64) { const v4u z = {0u, 0u, 0u, 0u}; *(LAS v4u*)(lds + row * 1024 + ch * 16) = (pos0 - 30 + row >= 0) ? uv[i] : z; } }
        }
        __syncthreads();
        {
            float uu[62];
#pragma unroll
            for (int i = 0; i < 62; ++i) uu[i] = bf2f(*(const LAS unsigned short*)(lds + i * 1024 + c * 2));
#pragma unroll
            for (int t = 0; t < 32; ++t) { float a = cb;
#pragma unroll
                for (int j = 0; j < CK; ++j) a = fmaf(w[j], uu[t + j], a);
                Y[t * 512 + c] = a; }
        }
        __syncthreads();
        v4u zwv[4];
#pragma unroll
        for (int tt = 0; tt < 4; ++tt) zwv[tt] = *(const GAS v4u*)(ZB + (size_t)(t0 + wave * 4 + tt) * 512 + 8 * lane);
        asm volatile("" ::: "memory");
#pragma unroll
        for (int tt = 0; tt < 4; ++tt) {
            const int t = wave * 4 + tt;
            const f32x4 y0 = *(const LAS f32x4*)(Y + t * 512 + 8 * lane), y1 = *(const LAS f32x4*)(Y + t * 512 + 8 * lane + 4);
            const v4u zw = zwv[tt];
            float s1 = (y0[0] + y0[1]) + (y0[2] + y0[3]) + (y1[0] + y1[1]) + (y1[2] + y1[3]);
            float s2 = (y0[0] * y0[0] + y0[1] * y0[1]) + (y0[2] * y0[2] + y0[3] * y0[3]) + (y1[0] * y1[0] + y1[1] * y1[1]) + (y1[2] * y1[2] + y1[3] * y1[3]);
#pragma unroll
            for (int o = 1; o < 64; o <<= 1) { s1 += __shfl_xor(s1, o); s2 += __shfl_xor(s2, o); }
            const float mu = s1 * (1.0f / 512.0f); float var = s2 * (1.0f / 512.0f) - mu * mu; var = var > 0.f ? var : 0.f;
            const float rs = 1.0f / sqrtf(var + EPS);
            float o_[8];
#pragma unroll
            for (int e = 0; e < 4; ++e) { const float v0 = (y0[e] - mu) * rs * lg0[e] + lb0[e], v1 = (y1[e] - mu) * rs * lg1[e] + lb1[e]; o_[e] = v0 * pg8::sigm_f(v0); o_[4 + e] = v1 * pg8::sigm_f(v1); }
            v4u ow; ow.x = cvtpk2(o_[0] * pg8::bflo(zw.x), o_[1] * pg8::bfhi(zw.x)); ow.y = cvtpk2(o_[2] * pg8::bflo(zw.y), o_[3] * pg8::bfhi(zw.y));
            ow.z = cvtpk2(o_[4] * pg8::bflo(zw.z), o_[5] * pg8::bfhi(zw.z)); ow.w = cvtpk2(o_[6] * pg8::bflo(zw.w), o_[7] * pg8::bfhi(zw.w));
            *(GAS v4u*)(ZB + (size_t)(t0 + t) * 512 + 8 * lane) = ow;
        }
        __syncthreads();
    }
}

#define IDX_SECTION(J0, BODY) if (nj > (J0)) { _Pragma("unroll") for (int j = (J0); j < (J0) + 16; ++j) { BODY } }
#define IDX_FORALL(BODY) do { IDX_SECTION(0, BODY) IDX_SECTION(16, BODY) IDX_SECTION(32, BODY) IDX_SECTION(48, BODY) } while (0)
constexpr int IDX_NB = 256;
constexpr int IDX_HIST_OFF = 132096, IDX_CAND_OFF = IDX_HIST_OFF + 8 * IDX_NB * 4, IDX_QST_OFF = IDX_CAND_OFF + 8 * 128 * 4, IDX_QST_BYTES = 8192 + 256;
static_assert(IDX_QST_OFF + 2 * IDX_QST_BYTES <= LDS_BYTES, "indexer LDS map");
__device__ __forceinline__ void idx_group(int it, int vcu, int G, int& b, int& jg) { if (G == 256) { b = it >> 1; jg = (it & 1) ? 511 - vcu : vcu; } else { const int idx = it * G + vcu; b = idx >> 9; jg = idx & 511; } }
__device__ __forceinline__ void idx_phase(const Args& A, LAS unsigned char* lds, int vcu, int G) {
    const int tid = threadIdx.x, lane = tid & 63, wid = __builtin_amdgcn_readfirstlane(tid >> 6), r32 = lane & 31, hi = lane >> 5;
    const bf16* QI = (const bf16*)(A.ws + WS_QI); const bf16* KI = (const bf16*)(A.ws + WS_KI); const float* WI = (const float*)(A.ws + WS_WI);
    unsigned long long* MASK = (unsigned long long*)(A.ws + WS_MASK);
    LAS unsigned* S = (LAS unsigned*)lds;
    LAS unsigned* HIST = (LAS unsigned*)(lds + IDX_HIST_OFF);
    LAS unsigned* CAND = (LAS unsigned*)(lds + IDX_CAND_OFF) + wid * 128;
    const int ngroups = M / 8; const int nit = (ngroups - vcu + G - 1) / G;
    const int qloc = 2 * ((r32 >> 2) & 1) + (r32 >> 4), hrow = 4 * ((r32 >> 3) & 1) + (r32 & 3);
    for (int i = tid; i < 8 * IDX_NB; i += NWAVES * 64) HIST[i] = 0u;
    v4u nqv = {0u, 0u, 0u, 0u}; f32x4 nwv = {0.f, 0.f, 0.f, 0.f};
    if (nit > 0) { int b0_, j0_; idx_group(0, vcu, G, b0_, j0_); const size_t g0 = (size_t)(b0_ * SEQ + j0_ * 8);
        *(LAS v4u*)(lds + IDX_QST_OFF + tid * 16) = *(const GAS v4u*)(QI + g0 * 512 + tid * 8);
        if (tid < 16) *(LAS f32x4*)(lds + IDX_QST_OFF + 8192 + tid * 16) = *(const GAS f32x4*)(WI + g0 * 8 + tid * 4); }
    if (nit > 1) { int b1_, j1_; idx_group(1, vcu, G, b1_, j1_); const size_t g1 = (size_t)(b1_ * SEQ + j1_ * 8);
        nqv = *(const GAS v4u*)(QI + g1 * 512 + tid * 8); if (tid < 16) nwv = *(const GAS f32x4*)(WI + g1 * 8 + tid * 4); }
    __syncthreads();
    bf16x8 kb0[4], kb1[4], kb2[4], kb3[4]; bool kpre = false;
#define IDX_LOADKB(dst, blk_, nblk_, base_) do { const int bb_ = (blk_) < (nblk_) ? (blk_) : (nblk_) - 1; const bf16* kp_ = (base_) + (size_t)bb_ * 2048; \
        _Pragma("unroll") for (int s = 0; s < 4; ++s) dst[s] = *(const GAS bf16x8*)(kp_ + 512 * s); } while (0)
    for (int it = 0; it < nit; ++it) {
        int b, jg; idx_group(it, vcu, G, b, jg);
        const int pos0 = jg * 8, q0 = b * SEQ + pos0, n = ((pos0 >> 6) + 1) * 64, nj = n >> 6;
        const bool trivial = n <= TOPK;
        if (!trivial) {
            LAS unsigned char* QST = lds + IDX_QST_OFF + (it & 1) * IDX_QST_BYTES; LAS float* WST = (LAS float*)(QST + 8192);
            bf16x8 afr[2][4]; float wv[2][2][8];
#pragma unroll
            for (int g = 0; g < 2; ++g) {
#pragma unroll
                for (int s = 0; s < 4; ++s) afr[g][s] = *(const LAS bf16x8*)(QST + (4 * g + qloc) * 1024 + hrow * 128 + s * 32 + hi * 16);
#pragma unroll
                for (int i = 0; i < 2; ++i) { const LAS f32x4* wp = (const LAS f32x4*)(WST + (4 * g + 2 * hi + i) * 8); const f32x4 w0 = wp[0], w1 = wp[1];
                    wv[g][i][0] = w0[0]; wv[g][i][1] = w0[1]; wv[g][i][2] = w0[2]; wv[g][i][3] = w0[3]; wv[g][i][4] = w1[0]; wv[g][i][5] = w1[1]; wv[g][i][6] = w1[2]; wv[g][i][7] = w1[3]; }
            }
            const int nblk = n >> 5;
            const bf16* KIb = KI + (size_t)(b * (SEQ / 32)) * 2048 + (hi * 32 + r32) * 8;
#define IDX_LOADK(dst, blk_) IDX_LOADKB(dst, blk_, nblk, KIb)
#define IDX_PUT(row_, key_, sc_) do { S[(row_) * 4096 + (key_)] = mono_key(sc_); const float s32_ = (sc_) * 32.0f; int bk_; asm("v_cvt_flr_i32_f32 %0, %1" : "=v"(bk_) : "v"(s32_)); bk_ += IDX_NB / 2; bk_ = bk_ < 0 ? 0 : (bk_ > IDX_NB - 1 ? IDX_NB - 1 : bk_); \
        __hip_atomic_fetch_add(HIST + (row_) * IDX_NB + bk_, 1u, __ATOMIC_RELAXED, __HIP_MEMORY_SCOPE_WORKGROUP); } while (0)
#define IDX_COMP(src, blk_) do { if ((blk_) < nblk) { _Pragma("unroll") for (int g = 0; g < 2; ++g) { \
            f32x16 acc = {0.f, 0.f, 0.f, 0.f, 0.f, 0.f, 0.f, 0.f, 0.f, 0.f, 0.f, 0.f, 0.f, 0.f, 0.f, 0.f}; \
            _Pragma("unroll") for (int s = 0; s < 4; ++s) acc = __builtin_amdgcn_mfma_f32_32x32x16_bf16(afr[g][s], src[s], acc, 0, 0, 0); \
            float s0 = 0.f, s1 = 0.f; \
            _Pragma("unroll") for (int r = 0; r < 8; ++r) { s0 = fmaf(relu_i(acc[r]), wv[g][0][r], s0); s1 = fmaf(relu_i(acc[8 + r]), wv[g][1][r], s1); } \
            IDX_PUT(4 * g + 2 * hi, (blk_) * 32 + r32, s0); IDX_PUT(4 * g + 2 * hi + 1, (blk_) * 32 + r32, s1); } } } while (0)
            if (!kpre) { IDX_LOADK(kb0, wid); IDX_LOADK(kb1, wid + 8); IDX_LOADK(kb2, wid + 16); }
            for (int blk = wid; blk < nblk; blk += 32) {
                IDX_LOADK(kb3, blk + 24); IDX_COMP(kb0, blk);
                IDX_LOADK(kb0, blk + 32); IDX_COMP(kb1, blk + 8);
                IDX_LOADK(kb1, blk + 40); IDX_COMP(kb2, blk + 16);
                IDX_LOADK(kb2, blk + 48); IDX_COMP(kb3, blk + 24);
            }
#undef IDX_LOADK
#undef IDX_COMP
#undef IDX_PUT
        }
        __syncthreads();
        unsigned uk[64]; v4u h0 = {0u, 0u, 0u, 0u};
#pragma unroll
        for (int j = 0; j < 64; ++j) uk[j] = 0u;
        if (!trivial) {
            LAS v4u* H4 = (LAS v4u*)(HIST + wid * IDX_NB) + lane; h0 = H4[0]; const v4u z4 = {0u, 0u, 0u, 0u}; H4[0] = z4;
            LAS unsigned* Sr = S + wid * 4096 + lane;
            { const int jend = (nj + 15) & ~15; for (int jj = nj; jj < jend; ++jj) Sr[64 * jj] = 0u; }
            IDX_FORALL(uk[j] = Sr[64 * j];);
        }
        if (it + 1 < nit) { LAS unsigned char* QN = lds + IDX_QST_OFF + ((it + 1) & 1) * IDX_QST_BYTES; *(LAS v4u*)(QN + tid * 16) = nqv; if (tid < 16) *(LAS f32x4*)(QN + 8192 + tid * 16) = nwv; }
        if (it + 2 < nit) { int b2_, j2_; idx_group(it + 2, vcu, G, b2_, j2_); const size_t g2 = (size_t)(b2_ * SEQ + j2_ * 8);
            nqv = *(const GAS v4u*)(QI + g2 * 512 + tid * 8); if (tid < 16) nwv = *(const GAS f32x4*)(WI + g2 * 8 + tid * 4); }
        asm volatile("s_waitcnt lgkmcnt(0)" ::: "memory");
        __builtin_amdgcn_s_barrier();
        asm volatile("" ::: "memory");
        if (trivial) { MASK[((size_t)(b * 64 + lane) << 12) + pos0 + wid] = lane < nj ? ~0ull : 0ull; continue; }
        {
            int bstar, cabove, cntb;
            {
                const int sl = (int)((h0.x + h0.y) + (h0.z + h0.w));
                int incl = sl;
#pragma unroll
                for (int o = 1; o < 64; o <<= 1) { const int t_ = __shfl_down(incl, o); incl += (lane + o < 64) ? t_ : 0; }
                const int above = incl - sl;
                const unsigned long long pm = __builtin_amdgcn_ballot_w64(above < TOPK && incl >= TOPK);
                const int lsel = (int)__builtin_ctzll(pm | (1ull << 63));
                int abv = __builtin_amdgcn_readlane(above, lsel);
                const int bn0 = __builtin_amdgcn_readlane((int)h0.x, lsel), bn1 = __builtin_amdgcn_readlane((int)h0.y, lsel), bn2 = __builtin_amdgcn_readlane((int)h0.z, lsel), bn3 = __builtin_amdgcn_readlane((int)h0.w, lsel);
                int kk = 3; cntb = bn3;
                if (abv + cntb < TOPK) { abv += cntb; kk = 2; cntb = bn2;
                if (abv + cntb < TOPK) { abv += cntb; kk = 1; cntb = bn1;
                if (abv + cntb < TOPK) { abv += cntb; kk = 0; cntb = bn0; } } }
                bstar = 4 * lsel + kk; cabove = abv;
            }
            const unsigned lo_key = bstar == 0 ? 1u : mono_key((float)(bstar - IDX_NB / 2) * (1.0f / 32.0f));
            const unsigned hi_key = bstar == IDX_NB - 1 ? 0xffffffffu : mono_key((float)(bstar - IDX_NB / 2 + 1) * (1.0f / 32.0f));
            unsigned L = lo_key, H = hi_key; int cH = cabove; bool exact = false; unsigned T = 0u;
            if (cntb <= 128) {
                const unsigned wdt = hi_key - lo_key; int base = 0;
                IDX_FORALL(const bool pr = (uk[j] - lo_key) < wdt; const unsigned long long bm = __builtin_amdgcn_ballot_w64(pr);
                           if (bm) { const int ps = base + (int)__builtin_amdgcn_mbcnt_hi((unsigned)(bm >> 32), __builtin_amdgcn_mbcnt_lo((unsigned)bm, 0u));
                                     if (pr) CAND[ps & 127] = uk[j]; base += __builtin_popcountll(bm); });
                const unsigned ck0 = (lane < cntb) ? CAND[lane] : 0u, ck1 = (lane + 64 < cntb) ? CAND[lane + 64] : 0u;
                const int r = TOPK - cabove;
                unsigned l2 = lo_key, h2 = hi_key;
                while (h2 - l2 > 1u) { const unsigned md = l2 + ((h2 - l2) >> 1); const int c = __builtin_popcountll(__builtin_amdgcn_ballot_w64(ck0 >= md)) + __builtin_popcountll(__builtin_amdgcn_ballot_w64(ck1 >= md)); if (c >= r) l2 = md; else h2 = md; }
                const int cge = __builtin_popcountll(__builtin_amdgcn_ballot_w64(ck0 >= l2)) + __builtin_popcountll(__builtin_amdgcn_ballot_w64(ck1 >= l2));
                if (cge == r) { exact = true; T = l2; } else { L = l2; H = l2 + 1u; cH = cabove + __builtin_popcountll(__builtin_amdgcn_ballot_w64(ck0 > l2)) + __builtin_popcountll(__builtin_amdgcn_ballot_w64(ck1 > l2)); }
            }
            for (int iter = 0; !exact && iter < 96 && H - L > 1u; ++iter) {
                unsigned mid = L + ((H - L) >> 1);
                if (iter < 24) { const float fm = 0.5f * (unmono_key(L) + unmono_key(H)); const unsigned km = mono_key(fm); if (km > L && km < H) mid = km; }
                mid = (unsigned)__builtin_amdgcn_readfirstlane((int)mid);
                int ca = 0, cb = 0;
                IDX_FORALL(if (j & 1) cb += (uk[j] >= mid) ? 1 : 0; else ca += (uk[j] >= mid) ? 1 : 0;);
                ca += cb; int c = 0;
#pragma unroll
                for (int bt = 0; bt < 7; ++bt) c += __builtin_popcountll(__builtin_amdgcn_ballot_w64(((ca >> bt) & 1) != 0)) << bt;
                if (c == TOPK) { T = mid; exact = true; break; }
                if (c > TOPK) L = mid; else { H = mid; cH = c; }
            }
            unsigned wlo = 0u, whi = 0u;
            int lane_o = lane; asm volatile("" : "+v"(lane_o));
            if (exact) {
                IDX_FORALL(const unsigned long long bm = __builtin_amdgcn_ballot_w64(uk[j] >= T); if (lane_o == j) { wlo = (unsigned)bm; whi = (unsigned)(bm >> 32); });
            } else {
                const int need = TOPK - cH; int run = 0;
                IDX_FORALL(const bool eq = uk[j] == L; const unsigned long long be = __builtin_amdgcn_ballot_w64(eq);
                           const int rk = run + (int)__builtin_amdgcn_mbcnt_hi((unsigned)(be >> 32), __builtin_amdgcn_mbcnt_lo((unsigned)be, 0u));
                           const bool sel = (uk[j] > L) || (eq && rk < need);
                           const unsigned long long bm = __builtin_amdgcn_ballot_w64(sel); run += __builtin_popcountll(be);
                           if (lane_o == j) { wlo = (unsigned)bm; whi = (unsigned)(bm >> 32); });
            }
            MASK[((size_t)(b * 64 + lane) << 12) + pos0 + wid] = ((unsigned long long)whi << 32) | wlo;
        }
    }
    __syncthreads();
#undef IDX_LOADKB
}
#undef IDX_SECTION
#undef IDX_FORALL

__device__ __forceinline__ void attn_phase(const Args& A, LAS unsigned char* lds, int vcu, int G) {
    const int tid = threadIdx.x, lane = tid & 63, wid = __builtin_amdgcn_readfirstlane(tid >> 6), r32 = lane & 31, hi = lane >> 5;
    bf16* Qb = (bf16*)(A.ws + WS_Q); const bf16* Kg = (const bf16*)(A.ws + WS_K); const bf16* Vg = (const bf16*)(A.ws + WS_V); const bf16* ZA = (const bf16*)(A.ws + WS_ZA);
    const unsigned long long* MASK = (const unsigned long long*)(A.ws + WS_MASK);
    constexpr int KB0 = 0, VT0 = 16384, VP = 192, VTB = 64 * VP, BTO = VT0 + 2 * VTB, OST = 49152;
    LAS float* BT = (LAS float*)(lds + BTO);
    { const float* BTg = (const float*)(A.ws + WS_BIAS); for (int i = tid; i < NH * BT_STRIDE; i += NWAVES * 64) BT[i] = BTg[i]; }
    __syncthreads();
    const int lkv = tid >> 3, lch = tid & 7;
    const int kst = lkv * 128 + ((lch ^ ((lkv >> 1) & 7)) << 4), vst = lkv * VP + lch * 16;
    const int vrd = (4 * hi + ((lane & 15) >> 2)) * VP + (16 * ((lane >> 4) & 1) + 4 * (lane & 3)) * 2;
    const int nunits = BATCH * NH * (SEQ / 256);
    for (int iu = 0;; ++iu) {
        const int ui = iu * G + vcu; if (ui >= nunits) break;
        int bh, qb;
        if (G == 256) { bh = vcu >> 2; const int s = vcu & 3; qb = (iu == 0) ? s : (iu == 1) ? 7 - s : (iu == 2) ? 8 + s : 15 - s; } else { bh = ui >> 4; qb = ui & 15; }
        const int b = bh >> 3, h = bh & 7, q0 = qb * 256, tokb = b * SEQ, NT = 4 * qb + 4, cw = 4 * qb + (wid >> 1);
        const int myq = q0 + 32 * wid + r32; const size_t tokq = (size_t)(tokb + myq);
        bf16x8 qf[4];
#pragma unroll
        for (int d0 = 0; d0 < 4; ++d0) qf[d0] = *(const GAS bf16x8*)(Qb + tokq * 512 + h * 64 + 16 * d0 + 8 * hi);
        float m = 0.f, l = 0.f;
        f32x16 ot0 = {0.f, 0.f, 0.f, 0.f, 0.f, 0.f, 0.f, 0.f, 0.f, 0.f, 0.f, 0.f, 0.f, 0.f, 0.f, 0.f}, ot1 = ot0;
        const bf16* kptr = Kg + (size_t)(tokb + lkv) * 512 + h * 64 + lch * 8;
        const bf16* vptr = Vg + (size_t)(tokb + lkv) * 512 + h * 64 + lch * 8;
        v4u kr = *(const GAS v4u*)kptr, vr = *(const GAS v4u*)vptr;
#define ATT_WRITE(buf) do { *(LAS v4u*)(lds + KB0 + (buf) * 8192 + kst) = kr; *(LAS v4u*)(lds + VT0 + (buf) * VTB + vst) = vr; } while (0)
        ATT_WRITE(0);
        if (NT > 1) { kr = *(const GAS v4u*)(kptr + (size_t)64 * 512); vr = *(const GAS v4u*)(vptr + (size_t)64 * 512); }
        const unsigned long long* mrow = MASK + ((size_t)(b * 64) << 12) + myq;
        unsigned long long mw = mrow[0];
        f32x16 nm = {0.f, 0.f, 0.f, 0.f, 0.f, 0.f, 0.f, 0.f, 0.f, 0.f, 0.f, 0.f, 0.f, 0.f, 0.f, 0.f};
        __syncthreads();
        for (int t = 0; t < NT; ++t) {
            const int cur = t & 1;
            unsigned mlo = (unsigned)mw >> (4 * hi), mhi = (unsigned)(mw >> 32) >> (4 * hi);
            asm volatile("" : "+v"(mlo), "+v"(mhi) :: "memory");
            if (t + 1 < NT) ATT_WRITE(cur ^ 1);
            asm volatile("" ::: "memory");
            if (t + 2 < NT) { kr = *(const GAS v4u*)(kptr + (size_t)(t + 2) * 64 * 512); vr = *(const GAS v4u*)(vptr + (size_t)(t + 2) * 64 * 512); }
            if (t + 1 < NT) mw = mrow[(size_t)(t + 1) << 12];
            if (t <= cw) {
                const LAS unsigned char* kb = lds + KB0 + cur * 8192; const LAS unsigned char* vt = lds + VT0 + cur * VTB;
                f32x16 p0 = nm, p1 = nm;
#pragma unroll
                for (int d0 = 0; d0 < 4; ++d0) {
                    const int sw = ((2 * d0 + hi) ^ ((r32 >> 1) & 7)) << 4;
                    const bf16x8 a0 = *(const LAS bf16x8*)(kb + r32 * 128 + sw), a1 = *(const LAS bf16x8*)(kb + (32 + r32) * 128 + sw);
                    p0 = __builtin_amdgcn_mfma_f32_32x32x16_bf16(a0, qf[d0], p0, 0, 0, 0);
                    p1 = __builtin_amdgcn_mfma_f32_32x32x16_bf16(a1, qf[d0], p1, 0, 0, 0);
                }
                if (64 * t + 63 >= q0 + 32 * wid - 90) {
                    const int base = 64 * t + 4 * hi - myq + 91; const LAS float* bt = BT + h * BT_STRIDE;
#pragma unroll
                    for (int r = 0; r < 16; ++r) { const int cr = (r & 3) + 8 * (r >> 2); int i0 = base + cr, i1 = base + 32 + cr; i0 = i0 < 0 ? 0 : i0; i1 = i1 < 0 ? 0 : i1; p0[r] += bt[i0]; p1[r] += bt[i1]; }
                }
                if ((t & 3) == 0) {
                float mx;
                { float xa = __builtin_fmaxf(__builtin_fmaxf(p0[0], p0[1]), p1[0]), xb = __builtin_fmaxf(__builtin_fmaxf(p0[2], p0[3]), p1[1]); xa = __builtin_fmaxf(__builtin_fmaxf(xa, p1[2]), p1[3]);
#pragma unroll
                  for (int r = 4; r < 16; r += 4) { xa = __builtin_fmaxf(__builtin_fmaxf(xa, p0[r]), p0[r + 1]); xb = __builtin_fmaxf(__builtin_fmaxf(xb, p0[r + 2]), p0[r + 3]); xa = __builtin_fmaxf(__builtin_fmaxf(xa, p1[r]), p1[r + 1]); xb = __builtin_fmaxf(__builtin_fmaxf(xb, p1[r + 2]), p1[r + 3]); }
                  mx = __builtin_fmaxf(xa, xb); }
                mx = __builtin_fmaxf(mx, __shfl_xor(mx, 32));
                if (t == 0 || __any(mx > 4.0f)) {
                    const float dl = (t == 0) ? mx : __builtin_fmaxf(mx, 0.f), al = (t == 0) ? 0.f : __builtin_amdgcn_exp2f(-dl); m += dl; l *= al;
#pragma unroll
                    for (int r = 0; r < 16; ++r) { p0[r] -= dl; p1[r] -= dl; ot0[r] *= al; ot1[r] *= al; nm[r] = -m; }
                }
                }
                float ps = 0.f, ps2 = 0.f;
#pragma unroll
                for (int r = 0; r < 16; ++r) { const int cr = (r & 3) + 8 * (r >> 2);
                    unsigned b0_, b1_; asm("v_bfe_i32 %0, %1, %2, 1" : "=v"(b0_) : "v"(mlo), "i"(cr)); asm("v_bfe_i32 %0, %1, %2, 1" : "=v"(b1_) : "v"(mhi), "i"(cr));
                    const float e0 = __uint_as_float(__float_as_uint(__builtin_amdgcn_exp2f(p0[r])) & b0_);
                    const float e1 = __uint_as_float(__float_as_uint(__builtin_amdgcn_exp2f(p1[r])) & b1_);
                    p0[r] = e0; p1[r] = e1; asm("v_add_f32_e32 %0, %1, %2" : "=v"(ps) : "v"(ps), "v"(e0)); asm("v_add_f32_e32 %0, %1, %2" : "=v"(ps2) : "v"(ps2), "v"(e1)); }
                ps += ps2;
                l += ps;
#pragma unroll
                for (int s = 0; s < 4; ++s) {
                    v4u pw;
                    if (s == 0) { pw.x = cvtpk2(p0[0], p0[1]); pw.y = cvtpk2(p0[2], p0[3]); pw.z = cvtpk2(p0[4], p0[5]); pw.w = cvtpk2(p0[6], p0[7]); }
                    else if (s == 1) { pw.x = cvtpk2(p0[8], p0[9]); pw.y = cvtpk2(p0[10], p0[11]); pw.z = cvtpk2(p0[12], p0[13]); pw.w = cvtpk2(p0[14], p0[15]); }
                    else if (s == 2) { pw.x = cvtpk2(p1[0], p1[1]); pw.y = cvtpk2(p1[2], p1[3]); pw.z = cvtpk2(p1[4], p1[5]); pw.w = cvtpk2(p1[6], p1[7]); }
                    else { pw.x = cvtpk2(p1[8], p1[9]); pw.y = cvtpk2(p1[10], p1[11]); pw.z = cvtpk2(p1[12], p1[13]); pw.w = cvtpk2(p1[14], p1[15]); }
                    const bf16x8 pb = __builtin_bit_cast(bf16x8, pw);
                    typedef short v4i16_t __attribute__((ext_vector_type(4)));
                    const LAS unsigned char* vrow = vt + vrd + (16 * s) * VP;
                    const v4i16_t lo0 = __builtin_amdgcn_ds_read_tr16_b64_v4i16((LAS v4i16_t*)(vrow)), hi0 = __builtin_amdgcn_ds_read_tr16_b64_v4i16((LAS v4i16_t*)(vrow + 8 * VP));
                    const v4i16_t lo1 = __builtin_amdgcn_ds_read_tr16_b64_v4i16((LAS v4i16_t*)(vrow + 64)), hi1 = __builtin_amdgcn_ds_read_tr16_b64_v4i16((LAS v4i16_t*)(vrow + 8 * VP + 64));
                    const bf16x8 a0w = {lo0[0], lo0[1], lo0[2], lo0[3], hi0[0], hi0[1], hi0[2], hi0[3]}, a1w = {lo1[0], lo1[1], lo1[2], lo1[3], hi1[0], hi1[1], hi1[2], hi1[3]};
                    ot0 = __builtin_amdgcn_mfma_f32_32x32x16_bf16(a0w, pb, ot0, 0, 0, 0);
                    ot1 = __builtin_amdgcn_mfma_f32_32x32x16_bf16(a1w, pb, ot1, 0, 0, 0);
                }
            }
            __syncthreads();
        }
#undef ATT_WRITE
        {
            const float lt = l + __shfl_xor(l, 32); const float inv = 1.0f / lt;
            LAS unsigned char* stg = lds + OST + wid * 4608;
#pragma unroll
            for (int i = 0; i < 8; ++i) { const int g = i & 3;
                const float o0 = ((i >> 2) ? ot1[4 * g] : ot0[4 * g]) * inv, o1 = ((i >> 2) ? ot1[4 * g + 1] : ot0[4 * g + 1]) * inv, o2 = ((i >> 2) ? ot1[4 * g + 2] : ot0[4 * g + 2]) * inv, o3 = ((i >> 2) ? ot1[4 * g + 3] : ot0[4 * g + 3]) * inv;
                u32x2 w; w.x = cvtpk2(o0, o1); w.y = cvtpk2(o2, o3);
                *(LAS u32x2*)(stg + r32 * 136 + (32 * (i >> 2) + 8 * g + 4 * hi) * 2) = w; }
            const int erow = lane >> 3, ech = lane & 7; const size_t rowtok = (size_t)(tokb + q0 + 32 * wid);
            v4u zv[4];
#pragma unroll
            for (int i = 0; i < 4; ++i) zv[i] = *(const GAS v4u*)(ZA + (rowtok + erow + 8 * i) * 512 + h * 64 + ech * 8);
            asm volatile("s_waitcnt lgkmcnt(0)" ::: "memory");
#pragma unroll
            for (int i = 0; i < 4; ++i) {
                const LAS unsigned char* sp = stg + (erow + 8 * i) * 136 + ech * 16;
                const u32x2 a = *(const LAS u32x2*)(sp), b2 = *(const LAS u32x2*)(sp + 8); const v4u z = zv[i];
                v4u w; w.x = cvtpk2(pg8::bflo(a.x) * pg8::bflo(z.x), pg8::bfhi(a.x) * pg8::bfhi(z.x)); w.y = cvtpk2(pg8::bflo(a.y) * pg8::bflo(z.y), pg8::bfhi(a.y) * pg8::bfhi(z.y));
                w.z = cvtpk2(pg8::bflo(b2.x) * pg8::bflo(z.z), pg8::bfhi(b2.x) * pg8::bfhi(z.z)); w.w = cvtpk2(pg8::bflo(b2.y) * pg8::bflo(z.w), pg8::bfhi(b2.y) * pg8::bfhi(z.w));
                *(GAS v4u*)(Qb + (rowtok + erow + 8 * i) * 512 + h * 64 + ech * 8) = w;
            }
        }
    }
}

__device__ __forceinline__ void final_phase(const Args& A, int vcu, int G) {
    const int tid = threadIdx.x, lane = tid & 63, wave = __builtin_amdgcn_readfirstlane(tid >> 6);
    const int gw = vcu * NWAVES + wave, NGW = G * NWAVES;
    const float* RS2 = (const float*)(A.ws + WS_RS2);
    f32x4 g[4];
#pragma unroll
    for (int j = 0; j < 4; ++j) g[j] = ((const GAS f32x4*)A.fin_g)[lane + 64 * j];
    const bf16* X2B = (const bf16*)(A.ws + WS_XB);
    for (int m0 = gw * 4; m0 < M; m0 += NGW * 4) {
        u32x2 w[4][4]; float r[4];
#pragma unroll
        for (int q = 0; q < 4; ++q) { r[q] = RS2[m0 + q]; const GAS u32x2* xi = (const GAS u32x2*)(X2B + (size_t)(m0 + q) * DM) + lane;
#pragma unroll
            for (int j = 0; j < 4; ++j) w[q][j] = __builtin_nontemporal_load(xi + 64 * j); }
        asm volatile("" ::: "memory");
#pragma unroll
        for (int q = 0; q < 4; ++q) { const float rs = 1.0f / sqrtf(r[q] * (1.0f / DM) + EPS); GAS f32x4* xo = (GAS f32x4*)(A.out + (size_t)(m0 + q) * DM) + lane;
#pragma unroll
            for (int j = 0; j < 4; ++j) { f32x4 v; v.x = pg8::bflo(w[q][j].x); v.y = pg8::bfhi(w[q][j].x); v.z = pg8::bflo(w[q][j].y); v.w = pg8::bfhi(w[q][j].y); __builtin_nontemporal_store(v * rs * g[j], xo + 64 * j); } }
    }
}
__global__ void __launch_bounds__(NWAVES * 64, 2) mk_fwd(Args args) {
    extern __shared__ __attribute__((aligned(16))) unsigned char lds_raw[];
    LAS unsigned char* lds = (LAS unsigned char*)lds_raw;
    volatile LAS unsigned* MISC = (volatile LAS unsigned*)(lds + MISC_OFF);
    const int tid = threadIdx.x;
    const int G = gridDim.x; int vcu; { const int bx = blockIdx.x; vcu = (G % 8 == 0) ? (bx % 8) * (G / 8) + bx / 8 : bx; }
    unsigned char* ws = args.ws;
    gu32* ctl = (gu32*)(ws + WS_CTL);
    for (int u = tid; u < (LDS_BYTES - LDSCTL_OFF) / 4; u += NWAVES * 64) ((LAS unsigned*)(lds + LDSCTL_OFF))[u] = 0u;
    __syncthreads();
    XcdBarrier bar; bar.bar = (unsigned*)(ctl + CW_BAR); bar.x = 0; bar.st = nullptr;
    if (N_LAUNCHES == 1) bar = xcd_barrier_post((unsigned*)(ctl + CW_BAR), MISC + 8);
#define GRID_BAR() do { if (N_LAUNCHES == 1) xcd_barrier(bar); } while (0)
    const int lo = args.ph_lo, hi = args.ph_hi;
#ifndef MK_PHASE_MASK
#define MK_PHASE_MASK 0xff
#endif
#define IN(k) ((((MK_PHASE_MASK) >> (k)) & 1) && lo <= (k) && (k) < hi)
#define BOTH(k) (IN(k) && IN((k) + 1))
    bf16* XB = (bf16*)(ws + WS_XB);
#ifdef MK_PROBE_A
    unsigned long long* ts = (unsigned long long*)(ws + WS_CTL + 256 * 1024);
#define STAMP(k) do { if (blockIdx.x == 0 && tid == 0) ts[k] = rt(); } while (0)
#else
#define STAMP(k) do { } while (0)
#endif
    STAMP(0);
    if (IN(0)) { p0_prologue(args, lds, vcu, G); if (BOTH(0)) GRID_BAR(); STAMP(1); }
    if (IN(1)) {
        pg8::Gemm g{XB, (const bf16*)(ws + WS_WIN), M, NWP, DM}; pg8::StaticOrder S; S.init(M, NWP, G, (int)blockIdx.x);
        pg8::EpiP1 E{(const float*)(ws + WS_RS0), (bf16*)(ws + WS_Q), (bf16*)(ws + WS_K), (bf16*)(ws + WS_V), (bf16*)(ws + WS_ZA), (bf16*)(ws + WS_QI), (bf16*)(ws + WS_U), (bf16*)(ws + WS_ZB),
                     (bf16*)(ws + WS_GA), (bf16*)(ws + WS_GB), (bf16*)(ws + WS_KI), (float*)(ws + WS_WI)};
        pg8::gemm_phase<pg8::EpiP1, pg8::StaticOrder, PG8_ALIGN, PG8_SP2>(lds, g, S, E);
        if (BOTH(1)) GRID_BAR();
        STAMP(2);
    }
    if (IN(2)) { conv_phase(args, lds, vcu, G); STAMP(9); idx_phase(args, lds, vcu, G); if (BOTH(2)) GRID_BAR(); STAMP(3); }
    if (IN(3)) { attn_phase(args, lds, vcu, G); if (BOTH(3)) GRID_BAR(); STAMP(4); }
    if (IN(4)) {
#ifndef MK_P4_MASK
#define MK_P4_MASK 7
#endif
        if (MK_P4_MASK & 1) {
            static_assert((WS_ZB - WS_Q) % ((size_t)256 * AW * 2) == 0 && (WS_WBB - WS_WBA) % ((size_t)256 * AW * 2) == 0, "second operand pair must sit a whole number of 256-row tiles behind the first");
            constexpr int DPM = (int)((WS_ZB - WS_Q) / ((size_t)256 * AW * 2)), DPN = (int)((WS_WBB - WS_WBA) / ((size_t)256 * AW * 2));
            pg8::Gemm g{(const bf16*)(ws + WS_Q), (const bf16*)(ws + WS_WBA), M, DM, AW}; pg8::PairOrder S; S.so.init(M, DM, G, (int)blockIdx.x); S.dpm = DPM; S.dpn = DPN;
            pg8::EpiBranch E{(const bf16*)(ws + WS_GA), (const bf16*)(ws + WS_GB), (bf16*)(ws + WS_K), DM, DPM, DPN};
            pg8::gemm_phase<pg8::EpiBranch, pg8::PairOrder, PG8_ALIGN, PG8_SP2>(lds, g, S, E); }
        if (MK_P4_MASK & 4) { int kple = PLE; asm volatile("" : "+s"(kple));
          pg8::Gemm g{(const bf16*)(ws + WS_PB), (const bf16*)(ws + WS_WPP), M, DM, kple}; pg8::StaticOrder S; S.init(M, DM, G, (int)blockIdx.x);
          pg8::EpiPlain E{(bf16*)(ws + WS_GB), DM};
          pg8::gemm_phase<pg8::EpiPlain, pg8::StaticOrder, PG8_ALIGN, PG8_SP2>(lds, g, S, E); }
        if (BOTH(4)) GRID_BAR();
        STAMP(5);
    }
    if (IN(5)) {
        pg8::Gemm g{(const bf16*)(ws + WS_K), (const bf16*)(ws + WS_WOUT), M, DM, DM}; pg8::StaticOrder S; S.init(M, DM, G, (int)blockIdx.x);
        pg8::EpiX1 E{XB, (bf16*)(ws + WS_GA), (float*)(ws + WS_RS1), DM};
        pg8::gemm_phase<pg8::EpiX1, pg8::StaticOrder, PG8_ALIGN, PG8_SP2>(lds, g, S, E);
        if (BOTH(5)) GRID_BAR();
        STAMP(6);
    }
    if (IN(6)) {
        pg8::Gemm g{(const bf16*)(ws + WS_GA), (const bf16*)(ws + WS_WPG), M, DM, DM}; pg8::StaticOrder S; S.init(M, DM, G, (int)blockIdx.x);
        pg8::EpiX2 E{(const bf16*)(ws + WS_GA), (const bf16*)(ws + WS_GB), XB, (const float*)(ws + WS_RS1), (float*)(ws + WS_RS2), DM, EPS};
        pg8::gemm_phase<pg8::EpiX2, pg8::StaticOrder, PG8_ALIGN, PG8_SP2>(lds, g, S, E);
        if (BOTH(6)) GRID_BAR();
        STAMP(7);
    }
    if (IN(7)) final_phase(args, vcu, G);
#ifdef MK_PROBE_A
    if (blockIdx.x == 0 && tid == 0) { const unsigned long long t8 = rt(); const unsigned long long dt = ts[MK_PROBE_HI] - ts[MK_PROBE_LO]; while (rt() < t8 + (unsigned long long)MK_PROBE_MULT * dt) __builtin_amdgcn_s_sleep(32); }
#endif
#undef IN
#undef BOTH
#undef GRID_BAR
}

extern "C" void kernel_launch(void* const* d_in, const int* in_sizes, int n_in, void* d_out, int out_size, void* d_ws, size_t ws_size, hipStream_t stream) {
    static int grid = 0;
    if (grid == 0) {
        if (n_in != 16 || out_size != M * DM || ws_size < WS_END) { fprintf(stderr, "kernel_launch: unexpected problem (n_in %d, out %d, ws %zu); nothing launched\n", n_in, out_size, ws_size); grid = -1; return; }
        int dev = 0, cus = 0, per_cu = 0;
        if (hipGetDevice(&dev) != hipSuccess || hipDeviceGetAttribute(&cus, hipDeviceAttributeMultiprocessorCount, dev) != hipSuccess) { grid = -1; return; }
        if (hipFuncSetAttribute((const void*)mk_fwd, hipFuncAttributeMaxDynamicSharedMemorySize, LDS_BYTES) != hipSuccess) { fprintf(stderr, "kernel_launch: hipFuncSetAttribute failed\n"); grid = -1; return; }
        if (hipOccupancyMaxActiveBlocksPerMultiprocessor(&per_cu, (const void*)mk_fwd, NWAVES * 64, LDS_BYTES) != hipSuccess || per_cu < 1) { fprintf(stderr, "kernel_launch: occupancy query says %d blocks per CU\n", per_cu); per_cu = 1; }
        (void)hipGetLastError();
        grid = cus;
    }
    if (grid < 0) return;
    if (hipMemsetAsync((char*)d_ws + WS_CTL, 0, CTL_ZERO_BYTES, stream) != hipSuccess) { fprintf(stderr, "kernel_launch: memset failed\n"); return; }
    Args a{};
    a.x = (const float*)d_in[0]; a.p = (const float*)d_in[1]; a.norm_in_g = (const float*)d_in[2]; a.w_in = (const float*)d_in[3]; a.conv_w = (const float*)d_in[4]; a.conv_b = (const float*)d_in[5];
    a.conv_ln_g = (const float*)d_in[6]; a.conv_ln_b = (const float*)d_in[7]; a.w_ba = (const float*)d_in[8]; a.w_bb = (const float*)d_in[9]; a.w_out = (const float*)d_in[10]; a.ple_g = (const float*)d_in[11];
    a.w_pg = (const float*)d_in[12]; a.w_pp = (const float*)d_in[13]; a.rel_bias = (const float*)d_in[14]; a.fin_g = (const float*)d_in[15];
    a.out = (float*)d_out; a.ws = (unsigned char*)d_ws;
    for (int li = 0; li < N_LAUNCHES; ++li) {
        if (N_LAUNCHES == 1) { a.ph_lo = 0; a.ph_hi = N_PHASES; } else { a.ph_lo = li; a.ph_hi = li + 1; }
        if (N_LAUNCHES == 1) {
            void* kargs[] = {&a};
            hipError_t e = hipLaunchCooperativeKernel((const void*)mk_fwd, dim3(grid), dim3(NWAVES * 64), kargs, LDS_BYTES, stream);
            if (e != hipSuccess) { (void)hipGetLastError(); fprintf(stderr, "kernel_launch: cooperative launch failed (%s); plain launch instead\n", hipGetErrorName(e)); hipLaunchKernelGGL(mk_fwd, dim3(grid), dim3(NWAVES * 64), LDS_BYTES, stream, a); }
        } else {
            hipLaunchKernelGGL(mk_fwd, dim3(grid), dim3(NWAVES * 64), LDS_BYTES, stream, a);
        }
        const hipError_t le = hipPeekAtLastError();
        if (le != hipSuccess) { fprintf(stderr, "kernel_launch: launch %d failed: %s\n", li, hipGetErrorName(le)); break; }
    }
}
```

```cpp
#include <hip/hip_runtime.h>
#include <cstdio>
#include <cstdint>
#define MK_N_LAUNCHES 1
namespace pg8 {
#define PG8_LAS __attribute__((address_space(3)))
typedef unsigned short bf16_t;
typedef short bf16x8 __attribute__((ext_vector_type(8)));
typedef float f32x4 __attribute__((ext_vector_type(4)));
typedef unsigned u32x4 __attribute__((ext_vector_type(4)));
constexpr int BM = 256, BK = 64, HALF = 128, HTB = HALF * BK * 2  , STAGE_BYTES = 8 * HTB, NXCD = 8, WGM = 8;

__host__ __device__ __forceinline__ int lds_byte(int r, int c) { return r * 128 + ((((c >> 3) ^ ((r >> 1) & 7)) & 7) << 4) + (c & 7) * 2; }
__host__ __device__ __forceinline__ void stage_rc(int b, int& R, int& C) { R = b >> 7; C = ((((b >> 4) & 7) ^ ((R >> 1) & 7)) & 7) * 8; }
__host__ __device__ __forceinline__ int perm32(int rho) { const int n = rho >> 4, i = rho & 15; return 8 * (i >> 2) + 4 * n + (i & 3); }

struct Unit { int pm, pn; };
struct Gemm { const bf16_t* A; const bf16_t* Bt; int M, N, K; };

struct StaticOrder {
    int nM, nN, nwg, G, c;
    __host__ __device__ void init(int M, int N, int G_, int c_) { nM = M / BM; nN = N / BM; nwg = nM * nN; G = G_; c = c_; }
    __host__ __device__ bool next(int i, Unit& u) const {
        const long L = (long)i * G + c; if (L >= nwg) return false;
        int wgid = (int)L; { const int q = nwg / NXCD, r = nwg % NXCD, xcd = wgid % NXCD, off = wgid / NXCD; wgid = (xcd < r ? xcd * (q + 1) : r * (q + 1) + (xcd - r) * q) + off; }
        const int nig = WGM * nN, gid = wgid / nig, fm = gid * WGM, gsz = (nM - fm) < WGM ? (nM - fm) : WGM;
        u.pm = fm + ((wgid % nig) % gsz); u.pn = (wgid % nig) / gsz; return true;
    }
    __device__ __forceinline__ void a_ready(const Unit&) const {}
    __device__ __forceinline__ void done(const Unit&) const {}
};

__device__ __forceinline__ unsigned cvt_pk_bf16(float lo, float hi) { unsigned r; asm volatile("v_cvt_pk_bf16_f32 %0, %1, %2" : "=v"(r) : "v"(lo), "v"(hi)); return r; }
typedef float f32x2 __attribute__((ext_vector_type(2)));
template <class Epi, class Sched, bool ALIGN_EPI = false, bool SP2 = false>
__device__ __forceinline__ void gemm_phase(PG8_LAS unsigned char* lds, const Gemm g, const Sched& S, const Epi& E) {
    const int tid = threadIdx.x, wid = __builtin_amdgcn_readfirstlane(tid >> 6), lane = tid & 63, wr = wid >> 2, wc = wid & 3, fr = lane & 15, fq = lane >> 4;
    const int K = g.K, nt = K / BK;
    unsigned voffA[2], voffB[2];
#pragma unroll
    for (int i = 0; i < 2; ++i) { int R, C; stage_rc(tid * 16 + i * 8192, R, C); const int Rb = Epi::PERM ? ((R & ~31) + perm32(R & 31)) : R;
        voffA[i] = (unsigned)(R * K + C) * 2u; voffB[i] = (unsigned)(Rb * K + C) * 2u; }
    const size_t kstep = (size_t)(BK * 2);
    const size_t hstep = (size_t)HALF * K * 2;
    const size_t tstep = 2 * hstep;
    const unsigned ldsw = (unsigned)wid * 1024u;
    const int aoff = lds_byte(wr * 64 + fr, fq * 8), boff = lds_byte(wc * 32 + fr, fq * 8);
    const int aoff1 = lds_byte(wr * 64 + fr, 32 + fq * 8), boff1 = lds_byte(wc * 32 + fr, 32 + fq * 8);
#define PG8_SA(b, h) (((b) * 2 + (h)) * HTB)
#define PG8_SB(b, h) ((4 + (b) * 2 + (h)) * HTB)
#define PG8_STAGE(bufoff, gbase, voff) do { _Pragma("unroll") for (int _i = 0; _i < 2; ++_i) \
        __builtin_amdgcn_global_load_lds((const unsigned*)((const char*)(gbase) + (voff)[_i]), (PG8_LAS unsigned*)(lds + (bufoff) + ldsw + _i * 8192), 16, 0, 0); } while (0)
#define PG8_LDA(dst, b, h) do { _Pragma("unroll") for (int m = 0; m < 4; ++m) _Pragma("unroll") for (int k = 0; k < 2; ++k) dst[m][k] = *(const PG8_LAS bf16x8*)(lds + PG8_SA(b, h) + (k ? aoff1 : aoff) + m * 2048); } while (0)
#define PG8_LDB(dst, b, h) do { _Pragma("unroll") for (int n = 0; n < 2; ++n) _Pragma("unroll") for (int k = 0; k < 2; ++k) dst[n][k] = *(const PG8_LAS bf16x8*)(lds + PG8_SB(b, h) + (k ? boff1 : boff) + n * 2048); } while (0)
#define PG8_MMA(ai, bj, At, Bt) do { __builtin_amdgcn_s_setprio(1); _Pragma("unroll") for (int m = 0; m < 4; ++m) _Pragma("unroll") for (int n = 0; n < 2; ++n) _Pragma("unroll") for (int k = 0; k < 2; ++k) \
        acc[ai][bj][m][n] = __builtin_amdgcn_mfma_f32_16x16x32_bf16(Bt[n][k], At[m][k], acc[ai][bj][m][n], 0, 0, 0); __builtin_amdgcn_s_setprio(0); } while (0)
#define PG8_WAIT_V(n) asm volatile("s_waitcnt vmcnt(" #n ")" ::: "memory")
#define PG8_WAIT_L(n) asm volatile("s_waitcnt lgkmcnt(" #n ")" ::: "memory")
#define PG8_BAR __builtin_amdgcn_s_barrier()
#define PG8_SCHED __builtin_amdgcn_sched_barrier(0)
    Unit cur, nxt; int ui = 0;
    if (!S.next(0, cur)) return;
    f32x4 acc[2][2][4][2];
#pragma unroll
    for (int a = 0; a < 2; ++a)
#pragma unroll
        for (int b = 0; b < 2; ++b)
#pragma unroll
            for (int m = 0; m < 4; ++m)
#pragma unroll
                for (int n = 0; n < 2; ++n) acc[a][b][m][n] = (f32x4){0.f, 0.f, 0.f, 0.f};
    bf16x8 At[4][2], B0[2][2], B1[2][2];
    const char* cA = (const char*)g.A + (size_t)cur.pm * tstep; const char* cB = (const char*)g.Bt + (size_t)cur.pn * tstep;
    S.a_ready(cur);
    if constexpr (SP2) {
        PG8_STAGE(PG8_SB(0, 0), cB, voffB); PG8_STAGE(PG8_SB(0, 1), cB + hstep, voffB); PG8_STAGE(PG8_SA(0, 0), cA, voffA); PG8_STAGE(PG8_SA(0, 1), cA + hstep, voffA);
        if (wr == 1) PG8_BAR;
        PG8_WAIT_V(2); PG8_BAR;
        PG8_STAGE(PG8_SB(1, 0), cB + kstep, voffB); PG8_STAGE(PG8_SA(1, 0), cA + kstep, voffA); PG8_STAGE(PG8_SB(1, 1), cB + hstep + kstep, voffB);
        PG8_WAIT_V(6); PG8_BAR;
    } else {
        PG8_STAGE(PG8_SB(0, 0), cB, voffB); PG8_STAGE(PG8_SA(0, 0), cA, voffA); PG8_STAGE(PG8_SB(0, 1), cB + hstep, voffB); PG8_STAGE(PG8_SA(0, 1), cA + hstep, voffA);
        if (wr == 1) PG8_BAR;
        PG8_WAIT_V(4); PG8_BAR;
        PG8_STAGE(PG8_SB(1, 0), cB + kstep, voffB); PG8_STAGE(PG8_SA(1, 0), cA + kstep, voffA); PG8_STAGE(PG8_SB(1, 1), cB + hstep + kstep, voffB);
        PG8_WAIT_V(6); PG8_BAR;
    }
    for (;;) {
        const bool has_next = S.next(ui + 1, nxt);
        const char* nA = has_next ? (const char*)g.A + (size_t)nxt.pm * tstep : cA; const char* nB = has_next ? (const char*)g.Bt + (size_t)nxt.pn * tstep : cB;
        for (int t = 0; t < nt; t += 2) {
            const bool last = (t == nt - 2);
            const char* a1 = cA + (size_t)(t + 1) * kstep;
            const char* a2 = last ? nA : cA + (size_t)(t + 2) * kstep; const char* b2 = last ? nB : cB + (size_t)(t + 2) * kstep;
            const char* a3 = a2 + kstep; const char* b3 = b2 + kstep;
            if (last && has_next) S.a_ready(nxt);
            if constexpr (SP2) {
            PG8_LDB(B0, 0, 0); PG8_LDB(B1, 0, 1); PG8_SCHED; PG8_LDA(At, 0, 0); PG8_STAGE(PG8_SA(1, 1), a1 + hstep, voffA);
            PG8_WAIT_V(8); PG8_WAIT_L(0); PG8_BAR; PG8_MMA(0, 0, At, B0); PG8_MMA(0, 1, At, B1); PG8_BAR; PG8_SCHED;
            PG8_LDA(At, 0, 1); PG8_STAGE(PG8_SB(0, 0), b2, voffB); PG8_STAGE(PG8_SB(0, 1), b2 + hstep, voffB); PG8_STAGE(PG8_SA(0, 0), a2, voffA);
            PG8_WAIT_V(8); PG8_WAIT_L(0); PG8_BAR; PG8_MMA(1, 0, At, B0); PG8_MMA(1, 1, At, B1); PG8_BAR; PG8_SCHED;
            PG8_LDB(B0, 1, 0); PG8_LDB(B1, 1, 1); PG8_SCHED; PG8_LDA(At, 1, 0); PG8_STAGE(PG8_SA(0, 1), a2 + hstep, voffA);
            PG8_WAIT_V(8); PG8_WAIT_L(0); PG8_BAR; PG8_MMA(0, 0, At, B0); PG8_MMA(0, 1, At, B1); PG8_BAR; PG8_SCHED;
            PG8_LDA(At, 1, 1); PG8_STAGE(PG8_SB(1, 0), b3, voffB); PG8_STAGE(PG8_SB(1, 1), b3 + hstep, voffB); PG8_STAGE(PG8_SA(1, 0), a3, voffA);
            PG8_WAIT_V(8); PG8_WAIT_L(0); PG8_BAR; PG8_MMA(1, 0, At, B0); PG8_MMA(1, 1, At, B1); PG8_BAR; PG8_SCHED;
            } else {
            PG8_LDB(B0, 0, 0); PG8_SCHED; PG8_LDA(At, 0, 0); PG8_STAGE(PG8_SA(1, 1), a1 + hstep, voffA);
            PG8_WAIT_L(8); PG8_BAR; PG8_WAIT_L(0); PG8_MMA(0, 0, At, B0); PG8_BAR; PG8_SCHED;
            PG8_LDB(B1, 0, 1); PG8_STAGE(PG8_SB(0, 0), b2, voffB);
            PG8_BAR; PG8_WAIT_L(0); PG8_MMA(0, 1, At, B1); PG8_BAR;
            PG8_LDA(At, 0, 1); PG8_STAGE(PG8_SA(0, 0), a2, voffA);
            PG8_BAR; PG8_WAIT_L(0); PG8_MMA(1, 0, At, B0); PG8_BAR; PG8_SCHED;
            PG8_STAGE(PG8_SB(0, 1), b2 + hstep, voffB);
            PG8_WAIT_V(6); PG8_BAR; PG8_MMA(1, 1, At, B1); PG8_BAR;
            PG8_LDB(B0, 1, 0); PG8_SCHED; PG8_LDA(At, 1, 0); PG8_STAGE(PG8_SA(0, 1), a2 + hstep, voffA);
            PG8_WAIT_L(8); PG8_BAR; PG8_WAIT_L(0); PG8_MMA(0, 0, At, B0); PG8_BAR; PG8_SCHED;
            PG8_LDB(B1, 1, 1); PG8_STAGE(PG8_SB(1, 0), b3, voffB);
            PG8_BAR; PG8_WAIT_L(0); PG8_MMA(0, 1, At, B1); PG8_BAR;
            PG8_LDA(At, 1, 1); PG8_STAGE(PG8_SA(1, 0), a3, voffA);
            PG8_BAR; PG8_WAIT_L(0); PG8_MMA(1, 0, At, B0); PG8_BAR; PG8_SCHED;
            PG8_STAGE(PG8_SB(1, 1), b3 + hstep, voffB);
            PG8_WAIT_V(6); PG8_BAR; PG8_MMA(1, 1, At, B1); PG8_BAR;
            }
        }
        if constexpr (ALIGN_EPI) { if (wr == 0) PG8_BAR; }
        if constexpr (!Epi::AFTER_DRAIN) { E(acc, cur, wr, wc, fr, fq); S.done(cur); }
        if (!has_next) break;
        if (!E.keep(cur)) {
#pragma unroll
        for (int a = 0; a < 2; ++a)
#pragma unroll
            for (int b = 0; b < 2; ++b)
#pragma unroll
                for (int m = 0; m < 4; ++m)
#pragma unroll
                    for (int n = 0; n < 2; ++n) acc[a][b][m][n] = (f32x4){0.f, 0.f, 0.f, 0.f};
        }
        cur = nxt; cA = nA; cB = nB; ++ui;
        if constexpr (ALIGN_EPI) { if (wr == 1) PG8_BAR; }
    }
    PG8_WAIT_V(0);
    if constexpr (!ALIGN_EPI) { if (wr == 0) PG8_BAR; }
    PG8_BAR;
    if constexpr (Epi::AFTER_DRAIN) { E.fused(acc, cur, wr, wc, fr, fq, lds, wid, lane); S.done(cur); }
#undef PG8_SA
#undef PG8_SB
#undef PG8_STAGE
#undef PG8_LDA
#undef PG8_LDB
#undef PG8_MMA
#undef PG8_WAIT_V
#undef PG8_WAIT_L
#undef PG8_BAR
#undef PG8_SCHED
}
}

#ifndef PG8_SP2
#define PG8_SP2 true
#endif
#ifndef PG8_ALIGN
#define PG8_ALIGN true
#endif
namespace pg8 {
typedef unsigned u32x2 __attribute__((ext_vector_type(2)));
__device__ __forceinline__ unsigned cvtpk(float lo, float hi) { typedef float f2_ __attribute__((ext_vector_type(2))); typedef __bf16 b2_ __attribute__((ext_vector_type(2))); f2_ v = {lo, hi}; b2_ b = __builtin_convertvector(v, b2_); return __builtin_bit_cast(unsigned, b); }
__device__ __forceinline__ float bflo(unsigned u) { return __uint_as_float(u << 16); }
__device__ __forceinline__ float bfhi(unsigned u) { return __uint_as_float(u & 0xffff0000u); }
__device__ __forceinline__ float sigm_f(float x) { return __builtin_amdgcn_rcpf(1.0f + __builtin_amdgcn_exp2f(-1.4426950408889634f * x)); }
constexpr float Q_SCALE = 0.125f * 1.4426950408889634f;
constexpr float IDX_SCALE = 0.125f * 0.35355339059327373f;

__device__ __forceinline__ void prefetch_tile_bf16(const bf16_t* base, int ldc, int row0, int col0, PG8_LAS unsigned char* lds, int tid) {
    PG8_LAS unsigned* scrap = (PG8_LAS unsigned*)(lds + 135168 + (tid >> 6) * 256);
#pragma unroll
    for (int j = 0; j < 2; ++j) { const int li = tid + 512 * j; const bf16_t* p = base + (size_t)(row0 + (li >> 2)) * ldc + col0 + (li & 3) * 64;
        __builtin_amdgcn_global_load_lds((const unsigned*)p, scrap, 4, 0, 0); }
}
struct EpiP1 {
    static constexpr bool PERM = true, AFTER_DRAIN = false;
    __device__ __forceinline__ bool keep(const Unit&) const { return false; }
    __device__ __forceinline__ void prefetch(const Unit&, PG8_LAS unsigned char*, int) const {}
    const float* rs0; bf16_t *Q, *Kb, *V, *ZA, *QI, *U, *ZB, *GA, *GB, *KI; float* WI;
    __device__ __forceinline__ void operator()(const f32x4 (&acc)[2][2][4][2], const Unit& u, int wr, int wc, int fr, int fq) const {
        const int pn = u.pn; const int row0 = u.pm * BM + wr * 64 + fr;
        int type = 0; bf16_t* base = Q; int ld = 512, colt = 0; float sc = 1.f;
        if (pn < 10) { const int sec = pn >> 1; base = sec == 0 ? Q : sec == 1 ? Kb : sec == 2 ? V : sec == 3 ? ZA : QI; colt = (pn & 1) * 256; type = (sec == 3) ? 1 : 0; if (sec == 0) sc = Q_SCALE; }
        else if (pn < 14) { type = 3; base = U; colt = (pn - 10) * 128; }
        else if (pn < 16) { type = 1; base = ZB; colt = (pn - 14) * 256; }
        else if (pn < 20) { type = 2; base = GA; ld = 1024; colt = (pn - 16) * 256; }
        else if (pn < 24) { type = 2; base = GB; ld = 1024; colt = (pn - 20) * 256; }
        else type = 4;
        const int col0 = colt + wc * 32 + 8 * fq;
        float rsv[2][4];
#pragma unroll
        for (int ai = 0; ai < 2; ++ai)
#pragma unroll
            for (int m = 0; m < 4; ++m) rsv[ai][m] = rs0[row0 + ai * HALF + m * 16];
        asm volatile("" ::: "memory");
#pragma unroll
        for (int ai = 0; ai < 2; ++ai)
#pragma unroll
            for (int m = 0; m < 4; ++m) {
                const int row = row0 + ai * HALF + m * 16;
                const float r = rsv[ai][m] * sc;
                if (type <= 2) {
                    bf16_t* rowp = base + (size_t)row * ld + col0;
#pragma unroll
                    for (int bj = 0; bj < 2; ++bj) {
                        f32x4 v0 = acc[ai][bj][m][0] * r, v1 = acc[ai][bj][m][1] * r;
                        if (type == 1) {
#pragma unroll
                            for (int e = 0; e < 4; ++e) { v0[e] = v0[e] * sigm_f(v0[e]); v1[e] = v1[e] * sigm_f(v1[e]); }
                        } else if (type == 2) {
#pragma unroll
                            for (int e = 0; e < 4; ++e) { v0[e] = sigm_f(v0[e]); v1[e] = sigm_f(v1[e]); }
                        }
                        u32x4 w; w.x = cvtpk(v0[0], v0[1]); w.y = cvtpk(v0[2], v0[3]); w.z = cvtpk(v1[0], v1[1]); w.w = cvtpk(v1[2], v1[3]);
                        if (type == 2) __builtin_nontemporal_store(w, (u32x4*)(rowp + bj * HALF));
                        else *(u32x4*)(rowp + bj * HALF) = w;
                    }
                } else if (type == 3) {
                    f32x4 a0 = acc[ai][0][m][0] * r, a1 = acc[ai][0][m][1] * r, b0 = acc[ai][1][m][0] * r, b1 = acc[ai][1][m][1] * r;
#pragma unroll
                    for (int e = 0; e < 4; ++e) { a0[e] = a0[e] * sigm_f(b0[e]); a1[e] = a1[e] * sigm_f(b1[e]); }
                    u32x4 w; w.x = cvtpk(a0[0], a0[1]); w.y = cvtpk(a0[2], a0[3]); w.z = cvtpk(a1[0], a1[1]); w.w = cvtpk(a1[2], a1[3]);
                    *(u32x4*)(base + (size_t)row * 512 + col0) = w;
                } else {
                    if (wc < 2) {
                        const f32x4 v0 = acc[ai][0][m][0] * r, v1 = acc[ai][0][m][1] * r;
                        u32x4 w; w.x = cvtpk(v0[0], v0[1]); w.y = cvtpk(v0[2], v0[3]); w.z = cvtpk(v1[0], v1[1]); w.w = cvtpk(v1[2], v1[3]);
                        const int c0 = wc * 32 + 8 * fq;
                        *(u32x4*)(KI + (size_t)(row >> 5) * 2048 + (((c0 >> 4) * 2 + ((c0 >> 3) & 1)) * 32 + (row & 31)) * 8) = w;
                    } else if (wc == 2 && fq == 0) {
                        const float rr = r * IDX_SCALE;
                        *(f32x4*)(WI + (size_t)row * 8) = acc[ai][0][m][0] * rr;
                        *(f32x4*)(WI + (size_t)row * 8 + 4) = acc[ai][0][m][1] * rr;
                    }
                }
            }
    }
};

template <bool ADD> struct EpiGate {
    static constexpr bool PERM = true, AFTER_DRAIN = false;
    __device__ __forceinline__ bool keep(const Unit&) const { return false; }
    __device__ __forceinline__ void prefetch(const Unit&, PG8_LAS unsigned char*, int) const {}
    const bf16_t* G; bf16_t* O; int ldc;
    __device__ __forceinline__ void operator()(const f32x4 (&acc)[2][2][4][2], const Unit& u, int wr, int wc, int fr, int fq) const {
        const int row0 = u.pm * BM + wr * 64 + fr, col0 = u.pn * BM + wc * 32 + 8 * fq;
#pragma unroll
        for (int ai = 0; ai < 2; ++ai) {
            u32x4 gv[4][2], ov[4][2];
#pragma unroll
            for (int m = 0; m < 4; ++m)
#pragma unroll
                for (int bj = 0; bj < 2; ++bj) { const size_t off = (size_t)(row0 + ai * HALF + m * 16) * ldc + col0 + bj * HALF; gv[m][bj] = *(const u32x4*)(G + off); if (ADD) ov[m][bj] = *(const u32x4*)(O + off); }
            asm volatile("" ::: "memory");
#pragma unroll
            for (int m = 0; m < 4; ++m)
#pragma unroll
                for (int bj = 0; bj < 2; ++bj) {
                    const size_t off = (size_t)(row0 + ai * HALF + m * 16) * ldc + col0 + bj * HALF; const u32x4 g = gv[m][bj];
                    f32x4 v0 = acc[ai][bj][m][0], v1 = acc[ai][bj][m][1];
                    v0[0] *= bflo(g.x); v0[1] *= bfhi(g.x); v0[2] *= bflo(g.y); v0[3] *= bfhi(g.y); v1[0] *= bflo(g.z); v1[1] *= bfhi(g.z); v1[2] *= bflo(g.w); v1[3] *= bfhi(g.w);
                    if (ADD) { const u32x4 o = ov[m][bj];
                        v0[0] += bflo(o.x); v0[1] += bfhi(o.x); v0[2] += bflo(o.y); v0[3] += bfhi(o.y); v1[0] += bflo(o.z); v1[1] += bfhi(o.z); v1[2] += bflo(o.w); v1[3] += bfhi(o.w); }
                    u32x4 w; w.x = cvtpk(v0[0], v0[1]); w.y = cvtpk(v0[2], v0[3]); w.z = cvtpk(v1[0], v1[1]); w.w = cvtpk(v1[2], v1[3]);
                    *(u32x4*)(O + off) = w;
                }
            asm volatile("" ::: "memory");
        }
    }
};

struct PairOrder {
    StaticOrder so; int dpm, dpn;
    __device__ bool next(int i, Unit& u) const { Unit b; if (!so.next(i >> 1, b)) return false; u.pm = b.pm + ((i & 1) ? dpm : 0); u.pn = b.pn + ((i & 1) ? dpn : 0); return true; }
    __device__ __forceinline__ void a_ready(const Unit&) const {}
    __device__ __forceinline__ void done(const Unit&) const {}
};
struct EpiBranch {
    static constexpr bool PERM = true, AFTER_DRAIN = false;
    const bf16_t* GA; const bf16_t* GB; bf16_t* O; int ldc, dpm, dpn;
    __device__ __forceinline__ bool keep(const Unit& u) const { return u.pm < dpm; }
    __device__ __forceinline__ void prefetch(const Unit& u, PG8_LAS unsigned char* lds, int tid) const { if (u.pm < dpm) { prefetch_tile_bf16(GA, ldc, u.pm * BM, u.pn * BM, lds, tid); prefetch_tile_bf16(GB, ldc, u.pm * BM, u.pn * BM, lds, tid); } }
    __device__ __forceinline__ void operator()(f32x4 (&acc)[2][2][4][2], const Unit& u, int wr, int wc, int fr, int fq) const {
        const bool second = u.pm >= dpm; const int pm = second ? u.pm - dpm : u.pm, pn = second ? u.pn - dpn : u.pn;
        const int row0 = pm * BM + wr * 64 + fr, col0 = pn * BM + wc * 32 + 8 * fq;
#pragma unroll
        for (int ai = 0; ai < 2; ++ai) {
            u32x4 gb[4][2], ga[4][2];
#pragma unroll
            for (int m = 0; m < 4; ++m)
#pragma unroll
                for (int bj = 0; bj < 2; ++bj) { const size_t off = (size_t)(row0 + ai * HALF + m * 16) * ldc + col0 + bj * HALF; gb[m][bj] = second ? __builtin_nontemporal_load((const u32x4*)(GB + off)) : *(const u32x4*)(GB + off); if (!second) ga[m][bj] = __builtin_nontemporal_load((const u32x4*)(GA + off)); }
            asm volatile("" ::: "memory");
#pragma unroll
            for (int m = 0; m < 4; ++m)
#pragma unroll
                for (int bj = 0; bj < 2; ++bj) {
                    const u32x4 b = gb[m][bj];
                    if (!second) {
                        const u32x4 a = ga[m][bj];
                        acc[ai][bj][m][0][0] *= bflo(a.x) * __builtin_amdgcn_rcpf(bflo(b.x)); acc[ai][bj][m][0][1] *= bfhi(a.x) * __builtin_amdgcn_rcpf(bfhi(b.x));
                        acc[ai][bj][m][0][2] *= bflo(a.y) * __builtin_amdgcn_rcpf(bflo(b.y)); acc[ai][bj][m][0][3] *= bfhi(a.y) * __builtin_amdgcn_rcpf(bfhi(b.y));
                        acc[ai][bj][m][1][0] *= bflo(a.z) * __builtin_amdgcn_rcpf(bflo(b.z)); acc[ai][bj][m][1][1] *= bfhi(a.z) * __builtin_amdgcn_rcpf(bfhi(b.z));
                        acc[ai][bj][m][1][2] *= bflo(a.w) * __builtin_amdgcn_rcpf(bflo(b.w)); acc[ai][bj][m][1][3] *= bfhi(a.w) * __builtin_amdgcn_rcpf(bfhi(b.w));
                    } else {
                        const f32x4 v0 = acc[ai][bj][m][0], v1 = acc[ai][bj][m][1];
                        u32x4 w; w.x = cvtpk(v0[0] * bflo(b.x), v0[1] * bfhi(b.x)); w.y = cvtpk(v0[2] * bflo(b.y), v0[3] * bfhi(b.y)); w.z = cvtpk(v1[0] * bflo(b.z), v1[1] * bfhi(b.z)); w.w = cvtpk(v1[2] * bflo(b.w), v1[3] * bfhi(b.w));
                        *(u32x4*)(O + (size_t)(row0 + ai * HALF + m * 16) * ldc + col0 + bj * HALF) = w;
                    }
                }
            asm volatile("" ::: "memory");
        }
    }
};

struct EpiPlain {
    static constexpr bool PERM = true, AFTER_DRAIN = false;
    __device__ __forceinline__ bool keep(const Unit&) const { return false; }
    __device__ __forceinline__ void prefetch(const Unit&, PG8_LAS unsigned char*, int) const {}
    bf16_t* O; int ldc;
    __device__ __forceinline__ void operator()(const f32x4 (&acc)[2][2][4][2], const Unit& u, int wr, int wc, int fr, int fq) const {
        const int row0 = u.pm * BM + wr * 64 + fr, col0 = u.pn * BM + wc * 32 + 8 * fq;
#pragma unroll
        for (int ai = 0; ai < 2; ++ai)
#pragma unroll
            for (int m = 0; m < 4; ++m) {
                bf16_t* rowp = O + (size_t)(row0 + ai * HALF + m * 16) * ldc + col0;
#pragma unroll
                for (int bj = 0; bj < 2; ++bj) {
                    const f32x4 v0 = acc[ai][bj][m][0], v1 = acc[ai][bj][m][1];
                    u32x4 w; w.x = cvtpk(v0[0], v0[1]); w.y = cvtpk(v0[2], v0[3]); w.z = cvtpk(v1[0], v1[1]); w.w = cvtpk(v1[2], v1[3]);
                    *(u32x4*)(rowp + bj * HALF) = w;
                }
            }
    }
};

struct EpiX1 {
    static constexpr bool PERM = true, AFTER_DRAIN = false;
    __device__ __forceinline__ bool keep(const Unit&) const { return false; }
    __device__ __forceinline__ void prefetch(const Unit& u, PG8_LAS unsigned char* lds, int tid) const { prefetch_tile_bf16(xin, ldc, u.pm * BM, u.pn * BM, lds, tid); }
    const bf16_t* xin; bf16_t* x1b; float* rss; int ldc;
    __device__ __forceinline__ void operator()(const f32x4 (&acc)[2][2][4][2], const Unit& u, int wr, int wc, int fr, int fq) const {
        const int row0 = u.pm * BM + wr * 64 + fr, col0 = u.pn * BM + wc * 32 + 8 * fq;
#pragma unroll
        for (int ai = 0; ai < 2; ++ai) {
            u32x4 xv[4][2];
#pragma unroll
            for (int m = 0; m < 4; ++m)
#pragma unroll
                for (int bj = 0; bj < 2; ++bj) xv[m][bj] = *(const u32x4*)(xin + (size_t)(row0 + ai * HALF + m * 16) * ldc + col0 + bj * HALF);
            asm volatile("" ::: "memory");
#pragma unroll
            for (int m = 0; m < 4; ++m) {
                const int row = row0 + ai * HALF + m * 16; const size_t off = (size_t)row * ldc + col0; float s = 0.f;
#pragma unroll
                for (int bj = 0; bj < 2; ++bj) {
                    const u32x4 xi = xv[m][bj];
                    f32x4 v0 = acc[ai][bj][m][0], v1 = acc[ai][bj][m][1];
                    v0[0] += bflo(xi.x); v0[1] += bfhi(xi.x); v0[2] += bflo(xi.y); v0[3] += bfhi(xi.y); v1[0] += bflo(xi.z); v1[1] += bfhi(xi.z); v1[2] += bflo(xi.w); v1[3] += bfhi(xi.w);
                    s += ((v0[0] * v0[0] + v0[1] * v0[1]) + (v0[2] * v0[2] + v0[3] * v0[3])) + ((v1[0] * v1[0] + v1[1] * v1[1]) + (v1[2] * v1[2] + v1[3] * v1[3]));
                    u32x4 w; w.x = cvtpk(v0[0], v0[1]); w.y = cvtpk(v0[2], v0[3]); w.z = cvtpk(v1[0], v1[1]); w.w = cvtpk(v1[2], v1[3]);
                    *(u32x4*)(x1b + off + bj * HALF) = w;
                }
                s += __shfl_xor(s, 16); s += __shfl_xor(s, 32);
                if (fq == 0) atomicAdd(rss + row, s);
            }
            asm volatile("" ::: "memory");
        }
    }
};

struct EpiX2 {
    static constexpr bool PERM = true, AFTER_DRAIN = false;
    __device__ __forceinline__ bool keep(const Unit&) const { return false; }
    __device__ __forceinline__ void prefetch(const Unit& u, PG8_LAS unsigned char* lds, int tid) const { prefetch_tile_bf16(this->e, ldc, u.pm * BM, u.pn * BM, lds, tid); }
    const bf16_t* x1b; const bf16_t* e; bf16_t* x2b; const float* rss1; float* rss2; int ldc; float eps;
    __device__ __forceinline__ void operator()(const f32x4 (&acc)[2][2][4][2], const Unit& u, int wr, int wc, int fr, int fq) const {
        const int row0 = u.pm * BM + wr * 64 + fr, col0 = u.pn * BM + wc * 32 + 8 * fq;
#pragma unroll
        for (int ai = 0; ai < 2; ++ai) {
            u32x4 xv[4][2], ev[4][2]; float rv[4];
#pragma unroll
            for (int m = 0; m < 4; ++m) { rv[m] = rss1[row0 + ai * HALF + m * 16];
#pragma unroll
                for (int bj = 0; bj < 2; ++bj) { const size_t off = (size_t)(row0 + ai * HALF + m * 16) * ldc + col0 + bj * HALF; xv[m][bj] = *(const u32x4*)(x1b + off); ev[m][bj] = *(const u32x4*)(e + off); } }
            asm volatile("" ::: "memory");
#pragma unroll
            for (int m = 0; m < 4; ++m) {
                const int row = row0 + ai * HALF + m * 16; const size_t off = (size_t)row * ldc + col0; float s = 0.f;
                const float rstd = 1.0f / sqrtf(rv[m] * (1.0f / 1024.0f) + eps);
#pragma unroll
                for (int bj = 0; bj < 2; ++bj) {
                    const u32x4 xi = xv[m][bj], ei = ev[m][bj];
                    const f32x4 a0 = acc[ai][bj][m][0] * rstd, a1 = acc[ai][bj][m][1] * rstd; f32x4 v0, v1;
                    v0[0] = bflo(xi.x) + sigm_f(a0[0]) * bflo(ei.x); v0[1] = bfhi(xi.x) + sigm_f(a0[1]) * bfhi(ei.x); v0[2] = bflo(xi.y) + sigm_f(a0[2]) * bflo(ei.y); v0[3] = bfhi(xi.y) + sigm_f(a0[3]) * bfhi(ei.y);
                    v1[0] = bflo(xi.z) + sigm_f(a1[0]) * bflo(ei.z); v1[1] = bfhi(xi.z) + sigm_f(a1[1]) * bfhi(ei.z); v1[2] = bflo(xi.w) + sigm_f(a1[2]) * bflo(ei.w); v1[3] = bfhi(xi.w) + sigm_f(a1[3]) * bfhi(ei.w);
                    s += ((v0[0] * v0[0] + v0[1] * v0[1]) + (v0[2] * v0[2] + v0[3] * v0[3])) + ((v1[0] * v1[0] + v1[1] * v1[1]) + (v1[2] * v1[2] + v1[3] * v1[3]));
                    u32x4 w; w.x = cvtpk(v0[0], v0[1]); w.y = cvtpk(v0[2], v0[3]); w.z = cvtpk(v1[0], v1[1]); w.w = cvtpk(v1[2], v1[3]);
                    *(u32x4*)(x2b + off + bj * HALF) = w;
                }
                s += __shfl_xor(s, 16); s += __shfl_xor(s, 32);
                if (fq == 0) atomicAdd(rss2 + row, s);
            }
            asm volatile("" ::: "memory");
        }
    }
};
}
constexpr int NWAVES = 8;
#ifndef MK_N_LAUNCHES
#define MK_N_LAUNCHES 1
#endif
constexpr int N_PHASES = 8;
constexpr int N_LAUNCHES = MK_N_LAUNCHES;

constexpr int BATCH = 8, SEQ = 4096, DM = 1024, M = BATCH * SEQ, AW = 512, NH = 8, HD = 64, PLE = 256, NWIN = 6216, NWP = 6400, CK = 31, TOPK = 256;
constexpr int O_Q = 0, O_KI = 2560, O_WI = 2624, O_GLU = 2632, O_ZB = 3656, O_GA = 4168, O_GB = 5192;
constexpr float EPS = 1e-6f;
constexpr int BT_STRIDE = 160;

constexpr size_t MiB = 1u << 20;
constexpr size_t WS_CTL = 0, CTL_ZERO_BYTES = 1 * MiB;
constexpr size_t WS_RS1 = 512 * 1024, WS_RS2 = 768 * 1024;
constexpr size_t WS_WIN = 2 * MiB;
constexpr size_t WS_WBA = 15 * MiB, WS_WBB = 16 * MiB, WS_WOUT = 17 * MiB, WS_WPG = 19 * MiB, WS_WPP = 21 * MiB;
constexpr size_t WS_BIAS = 21 * MiB + 512 * 1024;
constexpr size_t WS_RS0 = 22 * MiB;
constexpr size_t WS_WI = 23 * MiB;
constexpr size_t WS_KI = 24 * MiB;
constexpr size_t WS_MASK = 28 * MiB;
constexpr size_t WS_PB = 44 * MiB;
constexpr size_t WS_XB = 64 * MiB;
constexpr size_t WS_Q = 128 * MiB, WS_K = 160 * MiB, WS_V = 192 * MiB, WS_ZA = 224 * MiB, WS_QI = 256 * MiB, WS_U = 288 * MiB, WS_ZB = 320 * MiB;
constexpr size_t WS_GA = 352 * MiB, WS_GB = 416 * MiB, WS_END = 480 * MiB;
constexpr int CW_BAR = 4096;

constexpr int RING_BYTES = 131072;
constexpr int LDSCTL_OFF = RING_BYTES, MISC_OFF = LDSCTL_OFF + 320;
constexpr int LDS_BYTES = 161792;

#define GAS __attribute__((address_space(1)))
#define LAS __attribute__((address_space(3)))
typedef unsigned short bf16;
typedef unsigned v4u __attribute__((ext_vector_type(4)));
typedef float f32x4 __attribute__((ext_vector_type(4)));
typedef short bf16x8 __attribute__((ext_vector_type(8)));
typedef GAS unsigned gu32;
typedef GAS unsigned long long gu64;
#define RLX_AGENT __ATOMIC_RELAXED, __HIP_MEMORY_SCOPE_AGENT
#define LDS_WAIT() asm volatile("s_waitcnt lgkmcnt(0)" ::: "memory")
#define VM_WAIT() asm volatile("s_waitcnt vmcnt(0)" ::: "memory")
__device__ __forceinline__ unsigned long long rt() { return __builtin_amdgcn_s_memrealtime(); }
__device__ __forceinline__ unsigned f2bf(float f) { unsigned u = __builtin_bit_cast(unsigned, f); return (u + 0x7fffu + ((u >> 16) & 1u)) >> 16; }
__device__ __forceinline__ unsigned pk2(float lo, float hi) { return f2bf(lo) | (f2bf(hi) << 16); }

#define XB_TMO      128
#define XB_XCNT(j)  (256  + 64 * (j))
#define XB_XSUB(j)  (1280 + 64 * (j))
#define XB_XGEN(j)  (2304 + 64 * (j))
#define XB_TOP      3328
#define XB_TOPGEN   3392
#define XCD_BAR_WORDS 3456
#define XB_SPIN_CAP (1u << 18)

__device__ __forceinline__ unsigned xb_ld(unsigned* p)              { return __hip_atomic_load(p, __ATOMIC_RELAXED, __HIP_MEMORY_SCOPE_AGENT); }
__device__ __forceinline__ unsigned xb_add(unsigned* p, unsigned v) { return __hip_atomic_fetch_add(p, v, __ATOMIC_RELAXED, __HIP_MEMORY_SCOPE_AGENT); }
__device__ __forceinline__ unsigned xb_xcc_id() { return (unsigned)__builtin_amdgcn_s_getreg((3 << 11) | 20) & 0xFu; }
#define XB_SPIN(cond, bar) do { unsigned _sp = 0; while (cond) { __builtin_amdgcn_s_sleep(1); \
    if ((++_sp & 255u) == 0u) { if (xb_ld(&(bar)[XB_TMO])) break; if (_sp > XB_SPIN_CAP) { atomicAdd(&(bar)[XB_TMO], 1u); break; } } } } while (0)

struct XcdBarrier {
    unsigned* bar; unsigned x;
    volatile LAS unsigned* st;
};

__device__ __forceinline__ XcdBarrier xcd_barrier_post(unsigned* bar, volatile LAS unsigned* st) {
    XcdBarrier b; b.bar = bar; b.x = xb_xcc_id(); b.st = st;
    if (threadIdx.x == 0) (void)xb_add(&bar[XB_XCNT(b.x)], 1u);
    return b;
}
__device__ __forceinline__ void xcd_barrier_complete(unsigned* bar, unsigned x, unsigned& nloc, unsigned& nx) {
    const unsigned G = gridDim.x * gridDim.y * gridDim.z;
    unsigned sum, cnt, mine, sp = 0u;
    for (;;) {
        sum = 0u; cnt = 0u; mine = 0u;
#pragma unroll
        for (unsigned j = 0; j < 16; ++j) { const unsigned c = xb_ld(&bar[XB_XCNT(j)]); sum += c; cnt += (c > 0u) ? 1u : 0u; mine = (j == x) ? c : mine; }
        if (sum == G) break;
        __builtin_amdgcn_s_sleep(1);
        if ((++sp & 255u) == 0u) { if (xb_ld(&bar[XB_TMO])) break; if (sp > XB_SPIN_CAP) { atomicAdd(&bar[XB_TMO], 1u); break; } }
    }
    nloc = mine > 0u ? mine : 1u; nx = cnt > 0u ? cnt : 1u;
}

__device__ __forceinline__ void xcd_barrier(const XcdBarrier& b) {
    asm volatile("s_waitcnt vmcnt(0)" ::: "memory");
    __syncthreads();
    if (threadIdx.x == 0) {
        unsigned* bar = b.bar;
        __builtin_amdgcn_s_waitcnt(0);
        unsigned nloc = b.st[0], nx = b.st[1];
        if (nloc == 0u) { xcd_barrier_complete(bar, b.x, nloc, nx); b.st[0] = nloc; b.st[1] = nx; }
        const unsigned old = xb_add(&bar[XB_XSUB(b.x)], 1u);
        const unsigned gen = old / nloc;
        if (old + 1u == (gen + 1u) * nloc) {
            __builtin_amdgcn_fence(__ATOMIC_RELEASE, "agent");
            asm volatile("s_waitcnt vmcnt(0)" ::: "memory");
            const unsigned og = xb_add(&bar[XB_TOP], 1u);
            const unsigned tg = og / nx;
            if (og + 1u == (tg + 1u) * nx) xb_add(&bar[XB_TOPGEN], 1u);
            else XB_SPIN(xb_ld(&bar[XB_TOPGEN]) == tg, bar);
            __builtin_amdgcn_fence(__ATOMIC_ACQUIRE, "agent");
            xb_add(&bar[XB_XGEN(b.x)], 1u);
            asm volatile("s_waitcnt vmcnt(0)" ::: "memory");
        } else {
            XB_SPIN(xb_ld(&bar[XB_XGEN(b.x)]) == gen, bar);
            __builtin_amdgcn_fence(__ATOMIC_ACQUIRE, "agent");
            asm volatile("s_waitcnt vmcnt(0)" ::: "memory");
        }
    }
    __syncthreads();
}
struct Args {
    const float *x, *p, *norm_in_g, *w_in, *conv_w, *conv_b, *conv_ln_g, *conv_ln_b, *w_ba, *w_bb, *w_out, *ple_g, *w_pg, *w_pp, *rel_bias, *fin_g;
    float* out; unsigned char* ws; int ph_lo, ph_hi;
};
typedef float f32x16 __attribute__((ext_vector_type(16)));
typedef unsigned u32x2 __attribute__((ext_vector_type(2)));
__device__ __forceinline__ unsigned cvtpk2(float lo, float hi) { return pg8::cvtpk(lo, hi); }
__device__ __forceinline__ float bf2f(unsigned short h) { return __uint_as_float(((unsigned)h) << 16); }
__device__ __forceinline__ float wave_sum(float v) {
#pragma unroll
    for (int o = 1; o < 64; o <<= 1) v += __shfl_xor(v, o);
    return v;
}
__device__ __forceinline__ int t5_bucket(int rel) {
    const int base = rel > 0 ? 16 : 0; const int n = rel < 0 ? -rel : rel; int v;
    if (n < 8) v = n; else if (n < 12) v = 8; else if (n < 16) v = 9; else if (n < 23) v = 10; else if (n < 32) v = 11; else if (n < 46) v = 12; else if (n < 64) v = 13; else if (n < 91) v = 14; else v = 15;
    return base + v;
}
__device__ __forceinline__ unsigned mono_key(float f) { const unsigned u = __float_as_uint(f); return u ^ ((unsigned)((int)u >> 31) | 0x80000000u); }
__device__ __forceinline__ float relu_i(float x) { const int b = (int)__float_as_uint(x); return __uint_as_float((unsigned)(b > 0 ? b : 0)); }
__device__ __forceinline__ float unmono_key(unsigned k) { return __uint_as_float((k & 0x80000000u) ? (k & 0x7fffffffu) : ~k); }

__device__ __forceinline__ void p0_item(const float* W, int K, int Nsrc, int scol0, int nvalid, const float* g, bf16* WT, int drow0, int k0, LAS float* scr, int lane) {
    const int j = lane & 31, jv = j < nvalid ? j : 0; const float msk = j < nvalid ? 1.f : 0.f;
    const float* wp = W + (size_t)(k0 + (lane >> 5)) * Nsrc + scol0 + jv;
    float v[32];
#pragma unroll
    for (int i = 0; i < 32; ++i) v[i] = wp[(size_t)(2 * i) * Nsrc];
    const int c = lane & 7;
    f32x4 g0 = {1.f, 1.f, 1.f, 1.f}, g1 = g0;
    if (g) { g0 = *(const GAS f32x4*)(g + k0 + 8 * c); g1 = *(const GAS f32x4*)(g + k0 + 8 * c + 4); }
#pragma unroll
    for (int i = 0; i < 32; ++i) scr[(2 * i + (lane >> 5)) * 33 + j] = v[i] * msk;
    LDS_WAIT(); asm volatile("" ::: "memory");
#pragma unroll
    for (int jj = 0; jj < 4; ++jj) { const int n = (lane >> 3) + 8 * jj; const LAS float* s = scr + (8 * c) * 33 + n;
        v4u o; o.x = pk2(s[0 * 33] * g0[0], s[1 * 33] * g0[1]); o.y = pk2(s[2 * 33] * g0[2], s[3 * 33] * g0[3]); o.z = pk2(s[4 * 33] * g1[0], s[5 * 33] * g1[1]); o.w = pk2(s[6 * 33] * g1[2], s[7 * 33] * g1[3]);
        *(GAS v4u*)(WT + (size_t)(drow0 + n) * K + k0 + 8 * c) = o; }
    LDS_WAIT(); asm volatile("" ::: "memory");
}
__device__ __forceinline__ void win_block(int db, int& scol0, int& nvalid) {
    const int pn = db >> 3, sub = db & 7; nvalid = 32;
    if (pn < 10) scol0 = pn * 256 + sub * 32;
    else if (pn < 14) scol0 = O_GLU + (pn - 10) * 128 + (sub < 4 ? sub * 32 : 512 + (sub - 4) * 32);
    else if (pn < 16) scol0 = O_ZB + (pn - 14) * 256 + sub * 32;
    else if (pn < 20) scol0 = O_GA + (pn - 16) * 256 + sub * 32;
    else if (pn < 24) scol0 = O_GB + (pn - 20) * 256 + sub * 32;
    else { if (sub < 2) scol0 = O_KI + sub * 32; else if (sub == 2) { scol0 = O_WI; nvalid = 8; } else { scol0 = 0; nvalid = 0; } }
}
__device__ __forceinline__ void p0_prologue(const Args& A, LAS unsigned char* lds, int vcu, int G) {
    const int tid = threadIdx.x, lane = tid & 63, wave = __builtin_amdgcn_readfirstlane(tid >> 6);
    unsigned char* ws = A.ws;
    LAS float* scr = (LAS float*)(lds + wave * 16384);
    const bool itemw = wave >= 4;
    const int gw = itemw ? vcu * 4 + (wave - 4) : vcu * 4 + wave, NGW = G * 4;
    constexpr int I_IN = 200 * 16, I_BA = 32 * 8, I_BB = 32 * 8, I_OUT = 32 * 16, I_PG = 32 * 16, I_PP = 32 * 4;
    constexpr int NITEMS = I_IN + I_BA + I_BB + I_OUT + I_PG + I_PP;
    if (itemw) for (int it = gw; it < NITEMS; it += NGW) {
        int r = it; const float* W; const float* gsc = nullptr; bf16* WT; int K, Nsrc, sc0, nv = 32, drow0, k0;
        if (r < I_IN) { const int db = r >> 4; win_block(db, sc0, nv); W = A.w_in; K = DM; Nsrc = NWIN; gsc = A.norm_in_g; WT = (bf16*)(ws + WS_WIN); drow0 = db * 32; k0 = (r & 15) * 64; }
        else if ((r -= I_IN) < I_BA) { W = A.w_ba; K = AW; Nsrc = DM; sc0 = (r >> 3) * 32; WT = (bf16*)(ws + WS_WBA); drow0 = sc0; k0 = (r & 7) * 64; }
        else if ((r -= I_BA) < I_BB) { W = A.w_bb; K = AW; Nsrc = DM; sc0 = (r >> 3) * 32; WT = (bf16*)(ws + WS_WBB); drow0 = sc0; k0 = (r & 7) * 64; }
        else if ((r -= I_BB) < I_OUT) { W = A.w_out; K = DM; Nsrc = DM; sc0 = (r >> 4) * 32; WT = (bf16*)(ws + WS_WOUT); drow0 = sc0; k0 = (r & 15) * 64; }
        else if ((r -= I_OUT) < I_PG) { W = A.w_pg; K = DM; Nsrc = DM; sc0 = (r >> 4) * 32; gsc = A.ple_g; WT = (bf16*)(ws + WS_WPG); drow0 = sc0; k0 = (r & 15) * 64; }
        else { r -= I_PG; W = A.w_pp; K = PLE; Nsrc = DM; sc0 = (r >> 2) * 32; WT = (bf16*)(ws + WS_WPP); drow0 = sc0; k0 = (r & 3) * 64; }
        p0_item(W, K, Nsrc, sc0, nv, gsc, WT, drow0, k0, scr, lane);
    }
#ifdef MK_PROBE_A
    if (blockIdx.x == 0 && tid == 0) ((unsigned long long*)(ws + WS_CTL + 256 * 1024))[30] = rt();
#endif
    bf16* XB = (bf16*)(ws + WS_XB); float* RS0 = (float*)(ws + WS_RS0); bf16* PB = (bf16*)(ws + WS_PB);
    if (!itemw) for (int m0 = gw * 4; m0 < M; m0 += NGW * 4) {
        f32x4 v[4][4], pv[4]; float s[4];
#pragma unroll
        for (int r = 0; r < 4; ++r) { const GAS f32x4* xr = (const GAS f32x4*)(A.x + (size_t)(m0 + r) * DM) + lane;
#pragma unroll
            for (int j = 0; j < 4; ++j) v[r][j] = __builtin_nontemporal_load(xr + 64 * j);
            pv[r] = __builtin_nontemporal_load((const GAS f32x4*)(A.p + (size_t)(m0 + r) * PLE) + lane); }
#pragma unroll
        for (int r = 0; r < 4; ++r) { float t = 0.f;
#pragma unroll
            for (int j = 0; j < 4; ++j) t += (v[r][j].x * v[r][j].x + v[r][j].y * v[r][j].y) + (v[r][j].z * v[r][j].z + v[r][j].w * v[r][j].w);
            s[r] = t; }
#pragma unroll
        for (int o = 1; o < 64; o <<= 1) {
#pragma unroll
            for (int r = 0; r < 4; ++r) s[r] += __shfl_xor(s[r], o); }
#pragma unroll
        for (int r = 0; r < 4; ++r) {
            if (lane == 0) RS0[m0 + r] = 1.0f / sqrtf(s[r] * (1.0f / DM) + EPS);
            GAS u32x2* o8 = (GAS u32x2*)(XB + (size_t)(m0 + r) * DM) + lane;
#pragma unroll
            for (int j = 0; j < 4; ++j) { u32x2 w; w.x = cvtpk2(v[r][j].x, v[r][j].y); w.y = cvtpk2(v[r][j].z, v[r][j].w); o8[64 * j] = w; }
            u32x2 w; w.x = cvtpk2(pv[r].x, pv[r].y); w.y = cvtpk2(pv[r].z, pv[r].w);
            ((GAS u32x2*)(PB + (size_t)(m0 + r) * PLE))[lane] = w;
        }
    }
#ifdef MK_PROBE_A
    if (blockIdx.x == 0 && tid == 0) ((unsigned long long*)(ws + WS_CTL + 256 * 1024))[31] = rt();
#endif
    if (vcu == 0) {
        float* BTg = (float*)(ws + WS_BIAS);
        for (int i = tid; i < NH * BT_STRIDE; i += NWAVES * 64) { const int h = i / BT_STRIDE, k = i % BT_STRIDE; const int rel = k - 91; const int bk = t5_bucket(rel < 64 ? rel : 63);
            BTg[i] = (A.rel_bias[bk * NH + h] - A.rel_bias[15 * NH + h]) * 1.4426950408889634f; }
    }
}

__device__ __forceinline__ void conv_phase(const Args& A, LAS unsigned char* lds, int vcu, int G) {
    const int tid = threadIdx.x, lane = tid & 63, wave = __builtin_amdgcn_readfirstlane(tid >> 6);
    const bf16* U = (const bf16*)(A.ws + WS_U); bf16* ZB = (bf16*)(A.ws + WS_ZB);
    LAS float* Y = (LAS float*)(lds + 65536);
    const int c = tid;
    float w[CK];
#pragma unroll
    for (int j = 0; j < CK; ++j) w[j] = A.conv_w[j * 512 + c];
    const float cb = A.conv_b[c];
    f32x4 lg0 = *(const GAS f32x4*)(A.conv_ln_g + 8 * lane), lg1 = *(const GAS f32x4*)(A.conv_ln_g + 8 * lane + 4);
    f32x4 lb0 = *(const GAS f32x4*)(A.conv_ln_b + 8 * lane), lb1 = *(const GAS f32x4*)(A.conv_ln_b + 8 * lane + 4);
    for (int tile = vcu; tile < M / 32; tile += G) {
        const int t0 = tile * 32, pos0 = t0 & (SEQ - 1);
        {
            v4u uv[8];
#pragma unroll
            for (int i = 0; i < 8; ++i) { const int id = tid + 512 * i, row = id >> 6, ch = id & 63; const int rr = (pos0 - 30 + row >= 0 && id < 62 * 64) ? row : 30;
                uv[i] = *(const GAS v4u*)(U + (size_t)(t0 - 30 + rr) * 512 + ch * 8); }
#pragma unroll
            for (int i = 0; i < 8; ++i) { const int id = tid + 512 * i, row = id >> 6, ch = id & 63;
                if (id < 62 * 64) { const v4u z = {0u, 0u, 0u, 0u}; *(LAS v4u*)(lds + row * 1024 + ch * 16) = (pos0 - 30 + row >= 0) ? uv[i] : z; } }
        }
        __syncthreads();
        {
            float uu[62];
#pragma unroll
            for (int i = 0; i < 62; ++i) uu[i] = bf2f(*(const LAS unsigned short*)(lds + i * 1024 + c * 2));
#pragma unroll
            for (int t = 0; t < 32; ++t) { float a = cb;
#pragma unroll
                for (int j = 0; j < CK; ++j) a = fmaf(w[j], uu[t + j], a);
                Y[t * 512 + c] = a; }
        }
        __syncthreads();
        v4u zwv[4];
#pragma unroll
        for (int tt = 0; tt < 4; ++tt) zwv[tt] = *(const GAS v4u*)(ZB + (size_t)(t0 + wave * 4 + tt) * 512 + 8 * lane);
        asm volatile("" ::: "memory");
#pragma unroll
        for (int tt = 0; tt < 4; ++tt) {
            const int t = wave * 4 + tt;
            const f32x4 y0 = *(const LAS f32x4*)(Y + t * 512 + 8 * lane), y1 = *(const LAS f32x4*)(Y + t * 512 + 8 * lane + 4);
            const v4u zw = zwv[tt];
            float s1 = (y0[0] + y0[1]) + (y0[2] + y0[3]) + (y1[0] + y1[1]) + (y1[2] + y1[3]);
            float s2 = (y0[0] * y0[0] + y0[1] * y0[1]) + (y0[2] * y0[2] + y0[3] * y0[3]) + (y1[0] * y1[0] + y1[1] * y1[1]) + (y1[2] * y1[2] + y1[3] * y1[3]);
#pragma unroll
            for (int o = 1; o < 64; o <<= 1) { s1 += __shfl_xor(s1, o); s2 += __shfl_xor(s2, o); }
            const float mu = s1 * (1.0f / 512.0f); float var = s2 * (1.0f / 512.0f) - mu * mu; var = var > 0.f ? var : 0.f;
            const float rs = 1.0f / sqrtf(var + EPS);
            float o_[8];
#pragma unroll
            for (int e = 0; e < 4; ++e) { const float v0 = (y0[e] - mu) * rs * lg0[e] + lb0[e], v1 = (y1[e] - mu) * rs * lg1[e] + lb1[e]; o_[e] = v0 * pg8::sigm_f(v0); o_[4 + e] = v1 * pg8::sigm_f(v1); }
            v4u ow; ow.x = cvtpk2(o_[0] * pg8::bflo(zw.x), o_[1] * pg8::bfhi(zw.x)); ow.y = cvtpk2(o_[2] * pg8::bflo(zw.y), o_[3] * pg8::bfhi(zw.y));
            ow.z = cvtpk2(o_[4] * pg8::bflo(zw.z), o_[5] * pg8::bfhi(zw.z)); ow.w = cvtpk2(o_[6] * pg8::bflo(zw.w), o_[7] * pg8::bfhi(zw.w));
            *(GAS v4u*)(ZB + (size_t)(t0 + t) * 512 + 8 * lane) = ow;
        }
        __syncthreads();
    }
}

#define IDX_SECTION(J0, BODY) if (nj > (J0)) { _Pragma("unroll") for (int j = (J0); j < (J0) + 16; ++j) { BODY } }
#define IDX_FORALL(BODY) do { IDX_SECTION(0, BODY) IDX_SECTION(16, BODY) IDX_SECTION(32, BODY) IDX_SECTION(48, BODY) } while (0)
constexpr int IDX_NB = 256;
constexpr int IDX_HIST_OFF = 132096, IDX_CAND_OFF = IDX_HIST_OFF + 8 * IDX_NB * 4, IDX_QST_OFF = IDX_CAND_OFF + 8 * 128 * 4, IDX_QST_BYTES = 8192 + 256;
static_assert(IDX_QST_OFF + 2 * IDX_QST_BYTES <= LDS_BYTES, "indexer LDS map");
__device__ __forceinline__ void idx_group(int it, int vcu, int G, int& b, int& jg) { if (G == 256) { b = it >> 1; jg = (it & 1) ? 511 - vcu : vcu; } else { const int idx = it * G + vcu; b = idx >> 9; jg = idx & 511; } }
__device__ __forceinline__ void idx_phase(const Args& A, LAS unsigned char* lds, int vcu, int G) {
    const int tid = threadIdx.x, lane = tid & 63, wid = __builtin_amdgcn_readfirstlane(tid >> 6), r32 = lane & 31, hi = lane >> 5;
    const bf16* QI = (const bf16*)(A.ws + WS_QI); const bf16* KI = (const bf16*)(A.ws + WS_KI); const float* WI = (const float*)(A.ws + WS_WI);
    unsigned long long* MASK = (unsigned long long*)(A.ws + WS_MASK);
    LAS unsigned* S = (LAS unsigned*)lds;
    LAS unsigned* HIST = (LAS unsigned*)(lds + IDX_HIST_OFF);
    LAS unsigned* CAND = (LAS unsigned*)(lds + IDX_CAND_OFF) + wid * 128;
    const int ngroups = M / 8; const int nit = (ngroups - vcu + G - 1) / G;
    const int qloc = 2 * ((r32 >> 2) & 1) + (r32 >> 4), hrow = 4 * ((r32 >> 3) & 1) + (r32 & 3);
    for (int i = tid; i < 8 * IDX_NB; i += NWAVES * 64) HIST[i] = 0u;
    v4u nqv = {0u, 0u, 0u, 0u}; f32x4 nwv = {0.f, 0.f, 0.f, 0.f};
    if (nit > 0) { int b0_, j0_; idx_group(0, vcu, G, b0_, j0_); const size_t g0 = (size_t)(b0_ * SEQ + j0_ * 8);
        *(LAS v4u*)(lds + IDX_QST_OFF + tid * 16) = *(const GAS v4u*)(QI + g0 * 512 + tid * 8);
        if (tid < 16) *(LAS f32x4*)(lds + IDX_QST_OFF + 8192 + tid * 16) = *(const GAS f32x4*)(WI + g0 * 8 + tid * 4); }
    if (nit > 1) { int b1_, j1_; idx_group(1, vcu, G, b1_, j1_); const size_t g1 = (size_t)(b1_ * SEQ + j1_ * 8);
        nqv = *(const GAS v4u*)(QI + g1 * 512 + tid * 8); if (tid < 16) nwv = *(const GAS f32x4*)(WI + g1 * 8 + tid * 4); }
    __syncthreads();
    bf16x8 kb0[4], kb1[4], kb2[4], kb3[4]; bool kpre = false;
#define IDX_LOADKB(dst, blk_, nblk_, base_) do { const int bb_ = (blk_) < (nblk_) ? (blk_) : (nblk_) - 1; const bf16* kp_ = (base_) + (size_t)bb_ * 2048; \
        _Pragma("unroll") for (int s = 0; s < 4; ++s) dst[s] = *(const GAS bf16x8*)(kp_ + 512 * s); } while (0)
    for (int it = 0; it < nit; ++it) {
        int b, jg; idx_group(it, vcu, G, b, jg);
        const int pos0 = jg * 8, q0 = b * SEQ + pos0, n = ((pos0 >> 6) + 1) * 64, nj = n >> 6;
        const bool trivial = n <= TOPK;
        if (!trivial) {
            LAS unsigned char* QST = lds + IDX_QST_OFF + (it & 1) * IDX_QST_BYTES; LAS float* WST = (LAS float*)(QST + 8192);
            bf16x8 afr[2][4]; float wv[2][2][8];
#pragma unroll
            for (int g = 0; g < 2; ++g) {
#pragma unroll
                for (int s = 0; s < 4; ++s) afr[g][s] = *(const LAS bf16x8*)(QST + (4 * g + qloc) * 1024 + hrow * 128 + s * 32 + hi * 16);
#pragma unroll
                for (int i = 0; i < 2; ++i) { const LAS f32x4* wp = (const LAS f32x4*)(WST + (4 * g + 2 * hi + i) * 8); const f32x4 w0 = wp[0], w1 = wp[1];
                    wv[g][i][0] = w0[0]; wv[g][i][1] = w0[1]; wv[g][i][2] = w0[2]; wv[g][i][3] = w0[3]; wv[g][i][4] = w1[0]; wv[g][i][5] = w1[1]; wv[g][i][6] = w1[2]; wv[g][i][7] = w1[3]; }
            }
            const int nblk = n >> 5;
            const bf16* KIb = KI + (size_t)(b * (SEQ / 32)) * 2048 + (hi * 32 + r32) * 8;
#define IDX_LOADK(dst, blk_) IDX_LOADKB(dst, blk_, nblk, KIb)
#define IDX_PUT(row_, key_, sc_) do { S[(row_) * 4096 + (key_)] = mono_key(sc_); const float s32_ = (sc_) * 32.0f; int bk_; asm("v_cvt_flr_i32_f32 %0, %1" : "=v"(bk_) : "v"(s32_)); bk_ += IDX_NB / 2; bk_ = bk_ < 0 ? 0 : (bk_ > IDX_NB - 1 ? IDX_NB - 1 : bk_); \
        __hip_atomic_fetch_add(HIST + (row_) * IDX_NB + bk_, 1u, __ATOMIC_RELAXED, __HIP_MEMORY_SCOPE_WORKGROUP); } while (0)
#define IDX_COMP(src, blk_) do { if ((blk_) < nblk) { _Pragma("unroll") for (int g = 0; g < 2; ++g) { \
            f32x16 acc = {0.f, 0.f, 0.f, 0.f, 0.f, 0.f, 0.f, 0.f, 0.f, 0.f, 0.f, 0.f, 0.f, 0.f, 0.f, 0.f}; \
            _Pragma("unroll") for (int s = 0; s < 4; ++s) acc = __builtin_amdgcn_mfma_f32_32x32x16_bf16(afr[g][s], src[s], acc, 0, 0, 0); \
            float s0 = 0.f, s1 = 0.f; \
            _Pragma("unroll") for (int r = 0; r < 8; ++r) { s0 = fmaf(relu_i(acc[r]), wv[g][0][r], s0); s1 = fmaf(relu_i(acc[8 + r]), wv[g][1][r], s1); } \
            IDX_PUT(4 * g + 2 * hi, (blk_) * 32 + r32, s0); IDX_PUT(4 * g + 2 * hi + 1, (blk_) * 32 + r32, s1); } } } while (0)
            if (!kpre) { IDX_LOADK(kb0, wid); IDX_LOADK(kb1, wid + 8); IDX_LOADK(kb2, wid + 16); }
            for (int blk = wid; blk < nblk; blk += 32) {
                IDX_LOADK(kb3, blk + 24); IDX_COMP(kb0, blk);
                IDX_LOADK(kb0, blk + 32); IDX_COMP(kb1, blk + 8);
                IDX_LOADK(kb1, blk + 40); IDX_COMP(kb2, blk + 16);
                IDX_LOADK(kb2, blk + 48); IDX_COMP(kb3, blk + 24);
            }
#undef IDX_LOADK
#undef IDX_COMP
#undef IDX_PUT
        }
        __syncthreads();
        unsigned uk[64]; v4u h0 = {0u, 0u, 0u, 0u};
#pragma unroll
        for (int j = 0; j < 64; ++j) uk[j] = 0u;
        if (!trivial) {
            LAS v4u* H4 = (LAS v4u*)(HIST + wid * IDX_NB) + lane; h0 = H4[0]; const v4u z4 = {0u, 0u, 0u, 0u}; H4[0] = z4;
            LAS unsigned* Sr = S + wid * 4096 + lane;
            { const int jend = (nj + 15) & ~15; for (int jj = nj; jj < jend; ++jj) Sr[64 * jj] = 0u; }
            IDX_FORALL(uk[j] = Sr[64 * j];);
        }
        if (it + 1 < nit) { LAS unsigned char* QN = lds + IDX_QST_OFF + ((it + 1) & 1) * IDX_QST_BYTES; *(LAS v4u*)(QN + tid * 16) = nqv; if (tid < 16) *(LAS f32x4*)(QN + 8192 + tid * 16) = nwv; }
        if (it + 2 < nit) { int b2_, j2_; idx_group(it + 2, vcu, G, b2_, j2_); const size_t g2 = (size_t)(b2_ * SEQ + j2_ * 8);
            nqv = *(const GAS v4u*)(QI + g2 * 512 + tid * 8); if (tid < 16) nwv = *(const GAS f32x4*)(WI + g2 * 8 + tid * 4); }
        asm volatile("s_waitcnt lgkmcnt(0)" ::: "memory");
        __builtin_amdgcn_s_barrier();
        asm volatile("" ::: "memory");
        if (trivial) { MASK[((size_t)(b * 64 + lane) << 12) + pos0 + wid] = lane < nj ? ~0ull : 0ull; continue; }
        {
            int bstar, cabove, cntb;
            {
                const int sl = (int)((h0.x + h0.y) + (h0.z + h0.w));
                int incl = sl;
#pragma unroll
                for (int o = 1; o < 64; o <<= 1) { const int t_ = __shfl_down(incl, o); incl += (lane + o < 64) ? t_ : 0; }
                const int above = incl - sl;
                const unsigned long long pm = __builtin_amdgcn_ballot_w64(above < TOPK && incl >= TOPK);
                const int lsel = (int)__builtin_ctzll(pm | (1ull << 63));
                int abv = __builtin_amdgcn_readlane(above, lsel);
                const int bn0 = __builtin_amdgcn_readlane((int)h0.x, lsel), bn1 = __builtin_amdgcn_readlane((int)h0.y, lsel), bn2 = __builtin_amdgcn_readlane((int)h0.z, lsel), bn3 = __builtin_amdgcn_readlane((int)h0.w, lsel);
                int kk = 3; cntb = bn3;
                if (abv + cntb < TOPK) { abv += cntb; kk = 2; cntb = bn2;
                if (abv + cntb < TOPK) { abv += cntb; kk = 1; cntb = bn1;
                if (abv + cntb < TOPK) { abv += cntb; kk = 0; cntb = bn0; } } }
                bstar = 4 * lsel + kk; cabove = abv;
            }
            const unsigned lo_key = bstar == 0 ? 1u : mono_key((float)(bstar - IDX_NB / 2) * (1.0f / 32.0f));
            const unsigned hi_key = bstar == IDX_NB - 1 ? 0xffffffffu : mono_key((float)(bstar - IDX_NB / 2 + 1) * (1.0f / 32.0f));
            unsigned L = lo_key, H = hi_key; int cH = cabove; bool exact = false; unsigned T = 0u;
            if (cntb <= 128) {
                const unsigned wdt = hi_key - lo_key; int base = 0;
                IDX_FORALL(const bool pr = (uk[j] - lo_key) < wdt; const unsigned long long bm = __builtin_amdgcn_ballot_w64(pr);
                           if (bm) { const int ps = base + (int)__builtin_amdgcn_mbcnt_hi((unsigned)(bm >> 32), __builtin_amdgcn_mbcnt_lo((unsigned)bm, 0u));
                                     if (pr) CAND[ps & 127] = uk[j]; base += __builtin_popcountll(bm); });
                const unsigned ck0 = (lane < cntb) ? CAND[lane] : 0u, ck1 = (lane + 64 < cntb) ? CAND[lane + 64] : 0u;
                const int r = TOPK - cabove;
                unsigned l2 = lo_key, h2 = hi_key;
                while (h2 - l2 > 1u) { const unsigned md = l2 + ((h2 - l2) >> 1); const int c = __builtin_popcountll(__builtin_amdgcn_ballot_w64(ck0 >= md)) + __builtin_popcountll(__builtin_amdgcn_ballot_w64(ck1 >= md)); if (c >= r) l2 = md; else h2 = md; }
                const int cge = __builtin_popcountll(__builtin_amdgcn_ballot_w64(ck0 >= l2)) + __builtin_popcountll(__builtin_amdgcn_ballot_w64(ck1 >= l2));
                if (cge == r) { exact = true; T = l2; } else { L = l2; H = l2 + 1u; cH = cabove + __builtin_popcountll(__builtin_amdgcn_ballot_w64(ck0 > l2)) + __builtin_popcountll(__builtin_amdgcn_ballot_w64(ck1 > l2)); }
            }
            for (int iter = 0; !exact && iter < 96 && H - L > 1u; ++iter) {
                unsigned mid = L + ((H - L) >> 1);
                if (iter < 24) { const float fm = 0.5f * (unmono_key(L) + unmono_key(H)); const unsigned km = mono_key(fm); if (km > L && km < H) mid = km; }
                mid = (unsigned)__builtin_amdgcn_readfirstlane((int)mid);
                int ca = 0, cb = 0;
                IDX_FORALL(if (j & 1) cb += (uk[j] >= mid) ? 1 : 0; else ca += (uk[j] >= mid) ? 1 : 0;);
                ca += cb; int c = 0;
#pragma unroll
                for (int bt = 0; bt < 7; ++bt) c += __builtin_popcountll(__builtin_amdgcn_ballot_w64(((ca >> bt) & 1) != 0)) << bt;
                if (c == TOPK) { T = mid; exact = true; break; }
                if (c > TOPK) L = mid; else { H = mid; cH = c; }
            }
            unsigned wlo = 0u, whi = 0u;
            int lane_o = lane; asm volatile("" : "+v"(lane_o));
            if (exact) {
                IDX_FORALL(const unsigned long long bm = __builtin_amdgcn_ballot_w64(uk[j] >= T); if (lane_o == j) { wlo = (unsigned)bm; whi = (unsigned)(bm >> 32); });
            } else {
                const int need = TOPK - cH; int run = 0;
                IDX_FORALL(const bool eq = uk[j] == L; const unsigned long long be = __builtin_amdgcn_ballot_w64(eq);
                           const int rk = run + (int)__builtin_amdgcn_mbcnt_hi((unsigned)(be >> 32), __builtin_amdgcn_mbcnt_lo((unsigned)be, 0u));
                           const bool sel = (uk[j] > L) || (eq && rk < need);
                           const unsigned long long bm = __builtin_amdgcn_ballot_w64(sel); run += __builtin_popcountll(be);
                           if (lane_o == j) { wlo = (unsigned)bm; whi = (unsigned)(bm >> 32); });
            }
            MASK[((size_t)(b * 64 + lane) << 12) + pos0 + wid] = ((unsigned long long)whi << 32) | wlo;
        }
    }
    __syncthreads();
#undef IDX_LOADKB
}
#undef IDX_SECTION
#undef IDX_FORALL

__device__ __forceinline__ void attn_phase(const Args& A, LAS unsigned char* lds, int vcu, int G) {
    const int tid = threadIdx.x, lane = tid & 63, wid = __builtin_amdgcn_readfirstlane(tid >> 6), r32 = lane & 31, hi = lane >> 5;
    bf16* Qb = (bf16*)(A.ws + WS_Q); const bf16* Kg = (const bf16*)(A.ws + WS_K); const bf16* Vg = (const bf16*)(A.ws + WS_V); const bf16* ZA = (const bf16*)(A.ws + WS_ZA);
    const unsigned long long* MASK = (const unsigned long long*)(A.ws + WS_MASK);
    constexpr int KB0 = 0, VT0 = 16384, VP = 192, VTB = 64 * VP, BTO = VT0 + 2 * VTB, OST = 49152;
    LAS float* BT = (LAS float*)(lds + BTO);
    { const float* BTg = (const float*)(A.ws + WS_BIAS); for (int i = tid; i < NH * BT_STRIDE; i += NWAVES * 64) BT[i] = BTg[i]; }
    __syncthreads();
    const int lkv = tid >> 3, lch = tid & 7;
    const int kst = lkv * 128 + ((lch ^ ((lkv >> 1) & 7)) << 4), vst = lkv * VP + lch * 16;
    const int vrd = (4 * hi + ((lane & 15) >> 2)) * VP + (16 * ((lane >> 4) & 1) + 4 * (lane & 3)) * 2;
    const int nunits = BATCH * NH * (SEQ / 256);
    for (int iu = 0;; ++iu) {
        const int ui = iu * G + vcu; if (ui >= nunits) break;
        int bh, qb;
        if (G == 256) { bh = vcu >> 2; const int s = vcu & 3; qb = (iu == 0) ? s : (iu == 1) ? 7 - s : (iu == 2) ? 8 + s : 15 - s; } else { bh = ui >> 4; qb = ui & 15; }
        const int b = bh >> 3, h = bh & 7, q0 = qb * 256, tokb = b * SEQ, NT = 4 * qb + 4, cw = 4 * qb + (wid >> 1);
        const int myq = q0 + 32 * wid + r32; const size_t tokq = (size_t)(tokb + myq);
        bf16x8 qf[4];
#pragma unroll
        for (int d0 = 0; d0 < 4; ++d0) qf[d0] = *(const GAS bf16x8*)(Qb + tokq * 512 + h * 64 + 16 * d0 + 8 * hi);
        float m = 0.f, l = 0.f;
        f32x16 ot0 = {0.f, 0.f, 0.f, 0.f, 0.f, 0.f, 0.f, 0.f, 0.f, 0.f, 0.f, 0.f, 0.f, 0.f, 0.f, 0.f}, ot1 = ot0;
        const bf16* kptr = Kg + (size_t)(tokb + lkv) * 512 + h * 64 + lch * 8;
        const bf16* vptr = Vg + (size_t)(tokb + lkv) * 512 + h * 64 + lch * 8;
        v4u kr = *(const GAS v4u*)kptr, vr = *(const GAS v4u*)vptr;
#define ATT_WRITE(buf) do { *(LAS v4u*)(lds + KB0 + (buf) * 8192 + kst) = kr; *(LAS v4u*)(lds + VT0 + (buf) * VTB + vst) = vr; } while (0)
        ATT_WRITE(0);
        if (NT > 1) { kr = *(const GAS v4u*)(kptr + (size_t)64 * 512); vr = *(const GAS v4u*)(vptr + (size_t)64 * 512); }
        const unsigned long long* mrow = MASK + ((size_t)(b * 64) << 12) + myq;
        unsigned long long mw = mrow[0];
        f32x16 nm = {0.f, 0.f, 0.f, 0.f, 0.f, 0.f, 0.f, 0.f, 0.f, 0.f, 0.f, 0.f, 0.f, 0.f, 0.f, 0.f};
        __syncthreads();
        for (int t = 0; t < NT; ++t) {
            const int cur = t & 1;
            unsigned mlo = (unsigned)mw >> (4 * hi), mhi = (unsigned)(mw >> 32) >> (4 * hi);
            asm volatile("" : "+v"(mlo), "+v"(mhi) :: "memory");
            if (t + 1 < NT) ATT_WRITE(cur ^ 1);
            asm volatile("" ::: "memory");
            if (t + 2 < NT) { kr = *(const GAS v4u*)(kptr + (size_t)(t + 2) * 64 * 512); vr = *(const GAS v4u*)(vptr + (size_t)(t + 2) * 64 * 512); }
            if (t + 1 < NT) mw = mrow[(size_t)(t + 1) << 12];
            if (t <= cw) {
                const LAS unsigned char* kb = lds + KB0 + cur * 8192; const LAS unsigned char* vt = lds + VT0 + cur * VTB;
                f32x16 p0 = nm, p1 = nm;
#pragma unroll
                for (int d0 = 0; d0 < 4; ++d0) {
                    const int sw = ((2 * d0 + hi) ^ ((r32 >> 1) & 7)) << 4;
                    const bf16x8 a0 = *(const LAS bf16x8*)(kb + r32 * 128 + sw), a1 = *(const LAS bf16x8*)(kb + (32 + r32) * 128 + sw);
                    p0 = __builtin_amdgcn_mfma_f32_32x32x16_bf16(a0, qf[d0], p0, 0, 0, 0);
                    p1 = __builtin_amdgcn_mfma_f32_32x32x16_bf16(a1, qf[d0], p1, 0, 0, 0);
                }
                if (64 * t + 63 >= q0 + 32 * wid - 90) {
                    const int base = 64 * t + 4 * hi - myq + 91; const LAS float* bt = BT + h * BT_STRIDE;
#pragma unroll
                    for (int r = 0; r < 16; ++r) { const int cr = (r & 3) + 8 * (r >> 2); int i0 = base + cr, i1 = base + 32 + cr; i0 = i0 < 0 ? 0 : i0; i1 = i1 < 0 ? 0 : i1; p0[r] += bt[i0]; p1[r] += bt[i1]; }
                }
                if ((t & 3) == 0) {
                float mx;
                { float xa = __builtin_fmaxf(__builtin_fmaxf(p0[0], p0[1]), p1[0]), xb = __builtin_fmaxf(__builtin_fmaxf(p0[2], p0[3]), p1[1]); xa = __builtin_fmaxf(__builtin_fmaxf(xa, p1[2]), p1[3]);
#pragma unroll
                  for (int r = 4; r < 16; r += 4) { xa = __builtin_fmaxf(__builtin_fmaxf(xa, p0[r]), p0[r + 1]); xb = __builtin_fmaxf(__builtin_fmaxf(xb, p0[r + 2]), p0[r + 3]); xa = __builtin_fmaxf(__builtin_fmaxf(xa, p1[r]), p1[r + 1]); xb = __builtin_fmaxf(__builtin_fmaxf(xb, p1[r + 2]), p1[r + 3]); }
                  mx = __builtin_fmaxf(xa, xb); }
                mx = __builtin_fmaxf(mx, __shfl_xor(mx, 32));
                if (t == 0 || __any(mx > 4.0f)) {
                    const float dl = (t == 0) ? mx : __builtin_fmaxf(mx, 0.f), al = (t == 0) ? 0.f : __builtin_amdgcn_exp2f(-dl); m += dl; l *= al;
#pragma unroll
                    for (int r = 0; r < 16; ++r) { p0[r] -= dl; p1[r] -= dl; ot0[r] *= al; ot1[r] *= al; nm[r] = -m; }
                }
                }
                float ps = 0.f, ps2 = 0.f;
#pragma unroll
                for (int r = 0; r < 16; ++r) { const int cr = (r & 3) + 8 * (r >> 2);
                    unsigned b0_, b1_; asm("v_bfe_i32 %0, %1, %2, 1" : "=v"(b0_) : "v"(mlo), "i"(cr)); asm("v_bfe_i32 %0, %1, %2, 1" : "=v"(b1_) : "v"(mhi), "i"(cr));
                    const float e0 = __uint_as_float(__float_as_uint(__builtin_amdgcn_exp2f(p0[r])) & b0_);
                    const float e1 = __uint_as_float(__float_as_uint(__builtin_amdgcn_exp2f(p1[r])) & b1_);
                    p0[r] = e0; p1[r] = e1; asm("v_add_f32_e32 %0, %1, %2" : "=v"(ps) : "v"(ps), "v"(e0)); asm("v_add_f32_e32 %0, %1, %2" : "=v"(ps2) : "v"(ps2), "v"(e1)); }
                ps += ps2;
                l += ps;
#pragma unroll
                for (int s = 0; s < 4; ++s) {
                    v4u pw;
                    if (s == 0) { pw.x = cvtpk2(p0[0], p0[1]); pw.y = cvtpk2(p0[2], p0[3]); pw.z = cvtpk2(p0[4], p0[5]); pw.w = cvtpk2(p0[6], p0[7]); }
                    else if (s == 1) { pw.x = cvtpk2(p0[8], p0[9]); pw.y = cvtpk2(p0[10], p0[11]); pw.z = cvtpk2(p0[12], p0[13]); pw.w = cvtpk2(p0[14], p0[15]); }
                    else if (s == 2) { pw.x = cvtpk2(p1[0], p1[1]); pw.y = cvtpk2(p1[2], p1[3]); pw.z = cvtpk2(p1[4], p1[5]); pw.w = cvtpk2(p1[6], p1[7]); }
                    else { pw.x = cvtpk2(p1[8], p1[9]); pw.y = cvtpk2(p1[10], p1[11]); pw.z = cvtpk2(p1[12], p1[13]); pw.w = cvtpk2(p1[14], p1[15]); }
                    const bf16x8 pb = __builtin_bit_cast(bf16x8, pw);
                    typedef short v4i16_t __attribute__((ext_vector_type(4)));
                    const LAS unsigned char* vrow = vt + vrd + (16 * s) * VP;
                    const v4i16_t lo0 = __builtin_amdgcn_ds_read_tr16_b64_v4i16((LAS v4i16_t*)(vrow)), hi0 = __builtin_amdgcn_ds_read_tr16_b64_v4i16((LAS v4i16_t*)(vrow + 8 * VP));
                    const v4i16_t lo1 = __builtin_amdgcn_ds_read_tr16_b64_v4i16((LAS v4i16_t*)(vrow + 64)), hi1 = __builtin_amdgcn_ds_read_tr16_b64_v4i16((LAS v4i16_t*)(vrow + 8 * VP + 64));
                    const bf16x8 a0w = {lo0[0], lo0[1], lo0[2], lo0[3], hi0[0], hi0[1], hi0[2], hi0[3]}, a1w = {lo1[0], lo1[1], lo1[2], lo1[3], hi1[0], hi1[1], hi1[2], hi1[3]};
                    ot0 = __builtin_amdgcn_mfma_f32_32x32x16_bf16(a0w, pb, ot0, 0, 0, 0);
                    ot1 = __builtin_amdgcn_mfma_f32_32x32x16_bf16(a1w, pb, ot1, 0, 0, 0);
                }
            }
            __syncthreads();
        }
#undef ATT_WRITE
        {
            const float lt = l + __shfl_xor(l, 32); const float inv = 1.0f / lt;
            LAS unsigned char* stg = lds + OST + wid * 4608;
#pragma unroll
            for (int i = 0; i < 8; ++i) { const int g = i & 3;
                const float o0 = ((i >> 2) ? ot1[4 * g] : ot0[4 * g]) * inv, o1 = ((i >> 2) ? ot1[4 * g + 1] : ot0[4 * g + 1]) * inv, o2 = ((i >> 2) ? ot1[4 * g + 2] : ot0[4 * g + 2]) * inv, o3 = ((i >> 2) ? ot1[4 * g + 3] : ot0[4 * g + 3]) * inv;
                u32x2 w; w.x = cvtpk2(o0, o1); w.y = cvtpk2(o2, o3);
                *(LAS u32x2*)(stg + r32 * 136 + (32 * (i >> 2) + 8 * g + 4 * hi) * 2) = w; }
            const int erow = lane >> 3, ech = lane & 7; const size_t rowtok = (size_t)(tokb + q0 + 32 * wid);
            v4u zv[4];
#pragma unroll
            for (int i = 0; i < 4; ++i) zv[i] = *(const GAS v4u*)(ZA + (rowtok + erow + 8 * i) * 512 + h * 64 + ech * 8);
            asm volatile("s_waitcnt lgkmcnt(0)" ::: "memory");
#pragma unroll
            for (int i = 0; i < 4; ++i) {
                const LAS unsigned char* sp = stg + (erow + 8 * i) * 136 + ech * 16;
                const u32x2 a = *(const LAS u32x2*)(sp), b2 = *(const LAS u32x2*)(sp + 8); const v4u z = zv[i];
                v4u w; w.x = cvtpk2(pg8::bflo(a.x) * pg8::bflo(z.x), pg8::bfhi(a.x) * pg8::bfhi(z.x)); w.y = cvtpk2(pg8::bflo(a.y) * pg8::bflo(z.y), pg8::bfhi(a.y) * pg8::bfhi(z.y));
                w.z = cvtpk2(pg8::bflo(b2.x) * pg8::bflo(z.z), pg8::bfhi(b2.x) * pg8::bfhi(z.z)); w.w = cvtpk2(pg8::bflo(b2.y) * pg8::bflo(z.w), pg8::bfhi(b2.y) * pg8::bfhi(z.w));
                *(GAS v4u*)(Qb + (rowtok + erow + 8 * i) * 512 + h * 64 + ech * 8) = w;
            }
        }
    }
}

__device__ __forceinline__ void final_phase(const Args& A, int vcu, int G) {
    const int tid = threadIdx.x, lane = tid & 63, wave = __builtin_amdgcn_readfirstlane(tid >> 6);
    const int gw = vcu * NWAVES + wave, NGW = G * NWAVES;
    const float* RS2 = (const float*)(A.ws + WS_RS2);
    f32x4 g[4];
#pragma unroll
    for (int j = 0; j < 4; ++j) g[j] = ((const GAS f32x4*)A.fin_g)[lane + 64 * j];
    const bf16* X2B = (const bf16*)(A.ws + WS_XB);
    for (int m0 = gw * 4; m0 < M; m0 += NGW * 4) {
        u32x2 w[4][4]; float r[4];
#pragma unroll
        for (int q = 0; q < 4; ++q) { r[q] = RS2[m0 + q]; const GAS u32x2* xi = (const GAS u32x2*)(X2B + (size_t)(m0 + q) * DM) + lane;
#pragma unroll
            for (int j = 0; j < 4; ++j) w[q][j] = __builtin_nontemporal_load(xi + 64 * j); }
        asm volatile("" ::: "memory");
#pragma unroll
        for (int q = 0; q < 4; ++q) { const float rs = 1.0f / sqrtf(r[q] * (1.0f / DM) + EPS); GAS f32x4* xo = (GAS f32x4*)(A.out + (size_t)(m0 + q) * DM) + lane;
#pragma unroll
            for (int j = 0; j < 4; ++j) { f32x4 v; v.x = pg8::bflo(w[q][j].x); v.y = pg8::bfhi(w[q][j].x); v.z = pg8::bflo(w[q][j].y); v.w = pg8::bfhi(w[q][j].y); __builtin_nontemporal_store(v * rs * g[j], xo + 64 * j); } }
    }
}
__global__ void __launch_bounds__(NWAVES * 64, 2) mk_fwd(Args args) {
    extern __shared__ __attribute__((aligned(16))) unsigned char lds_raw[];
    LAS unsigned char* lds = (LAS unsigned char*)lds_raw;
    volatile LAS unsigned* MISC = (volatile LAS unsigned*)(lds + MISC_OFF);
    const int tid = threadIdx.x;
    const int G = gridDim.x; int vcu; { const int bx = blockIdx.x; vcu = (G % 8 == 0) ? (bx % 8) * (G / 8) + bx / 8 : bx; }
    unsigned char* ws = args.ws;
    gu32* ctl = (gu32*)(ws + WS_CTL);
    for (int u = tid; u < (LDS_BYTES - LDSCTL_OFF) / 4; u += NWAVES * 64) ((LAS unsigned*)(lds + LDSCTL_OFF))[u] = 0u;
    __syncthreads();
    XcdBarrier bar; bar.bar = (unsigned*)(ctl + CW_BAR); bar.x = 0; bar.st = nullptr;
    if (N_LAUNCHES == 1) bar = xcd_barrier_post((unsigned*)(ctl + CW_BAR), MISC + 8);
#define GRID_BAR() do { if (N_LAUNCHES == 1) xcd_barrier(bar); } while (0)
    const int lo = args.ph_lo, hi = args.ph_hi;
#ifndef MK_PHASE_MASK
#define MK_PHASE_MASK 0xff
#endif
#define IN(k) ((((MK_PHASE_MASK) >> (k)) & 1) && lo <= (k) && (k) < hi)
#define BOTH(k) (IN(k) && IN((k) + 1))
    bf16* XB = (bf16*)(ws + WS_XB);
#ifdef MK_PROBE_A
    unsigned long long* ts = (unsigned long long*)(ws + WS_CTL + 256 * 1024);
#define STAMP(k) do { if (blockIdx.x == 0 && tid == 0) ts[k] = rt(); } while (0)
#else
#define STAMP(k) do { } while (0)
#endif
    STAMP(0);
    if (IN(0)) { p0_prologue(args, lds, vcu, G); if (BOTH(0)) GRID_BAR(); STAMP(1); }
    if (IN(1)) {
        pg8::Gemm g{XB, (const bf16*)(ws + WS_WIN), M, NWP, DM}; pg8::StaticOrder S; S.init(M, NWP, G, (int)blockIdx.x);
        pg8::EpiP1 E{(const float*)(ws + WS_RS0), (bf16*)(ws + WS_Q), (bf16*)(ws + WS_K), (bf16*)(ws + WS_V), (bf16*)(ws + WS_ZA), (bf16*)(ws + WS_QI), (bf16*)(ws + WS_U), (bf16*)(ws + WS_ZB),
                     (bf16*)(ws + WS_GA), (bf16*)(ws + WS_GB), (bf16*)(ws + WS_KI), (float*)(ws + WS_WI)};
        pg8::gemm_phase<pg8::EpiP1, pg8::StaticOrder, PG8_ALIGN, PG8_SP2>(lds, g, S, E);
        if (BOTH(1)) GRID_BAR();
        STAMP(2);
    }
    if (IN(2)) { conv_phase(args, lds, vcu, G); STAMP(9); idx_phase(args, lds, vcu, G); if (BOTH(2)) GRID_BAR(); STAMP(3); }
    if (IN(3)) { attn_phase(args, lds, vcu, G); if (BOTH(3)) GRID_BAR(); STAMP(4); }
    if (IN(4)) {
#ifndef MK_P4_MASK
#define MK_P4_MASK 7
#endif
        if (MK_P4_MASK & 1) {
            static_assert((WS_ZB - WS_Q) % ((size_t)256 * AW * 2) == 0 && (WS_WBB - WS_WBA) % ((size_t)256 * AW * 2) == 0, "second operand pair must sit a whole number of 256-row tiles behind the first");
            constexpr int DPM = (int)((WS_ZB - WS_Q) / ((size_t)256 * AW * 2)), DPN = (int)((WS_WBB - WS_WBA) / ((size_t)256 * AW * 2));
            pg8::Gemm g{(const bf16*)(ws + WS_Q), (const bf16*)(ws + WS_WBA), M, DM, AW}; pg8::PairOrder S; S.so.init(M, DM, G, (int)blockIdx.x); S.dpm = DPM; S.dpn = DPN;
            pg8::EpiBranch E{(const bf16*)(ws + WS_GA), (const bf16*)(ws + WS_GB), (bf16*)(ws + WS_K), DM, DPM, DPN};
            pg8::gemm_phase<pg8::EpiBranch, pg8::PairOrder, PG8_ALIGN, PG8_SP2>(lds, g, S, E); }
        if (MK_P4_MASK & 4) { int kple = PLE; asm volatile("" : "+s"(kple));
          pg8::Gemm g{(const bf16*)(ws + WS_PB), (const bf16*)(ws + WS_WPP), M, DM, kple}; pg8::StaticOrder S; S.init(M, DM, G, (int)blockIdx.x);
          pg8::EpiPlain E{(bf16*)(ws + WS_GB), DM};
          pg8::gemm_phase<pg8::EpiPlain, pg8::StaticOrder, PG8_ALIGN, PG8_SP2>(lds, g, S, E); }
        if (BOTH(4)) GRID_BAR();
        STAMP(5);
    }
    if (IN(5)) {
        pg8::Gemm g{(const bf16*)(ws + WS_K), (const bf16*)(ws + WS_WOUT), M, DM, DM}; pg8::StaticOrder S; S.init(M, DM, G, (int)blockIdx.x);
        pg8::EpiX1 E{XB, (bf16*)(ws + WS_GA), (float*)(ws + WS_RS1), DM};
        pg8::gemm_phase<pg8::EpiX1, pg8::StaticOrder, PG8_ALIGN, PG8_SP2>(lds, g, S, E);
        if (BOTH(5)) GRID_BAR();
        STAMP(6);
    }
    if (IN(6)) {
        pg8::Gemm g{(const bf16*)(ws + WS_GA), (const bf16*)(ws + WS_WPG), M, DM, DM}; pg8::StaticOrder S; S.init(M, DM, G, (int)blockIdx.x);
        pg8::EpiX2 E{(const bf16*)(ws + WS_GA), (const bf16*)(ws + WS_GB), XB, (const float*)(ws + WS_RS1), (float*)(ws + WS_RS2), DM, EPS};
        pg8::gemm_phase<pg8::EpiX2, pg8::StaticOrder, PG8_ALIGN, PG8_SP2>(lds, g, S, E);
        if (BOTH(6)) GRID_BAR();
        STAMP(7);
    }
    if (IN(7)) final_phase(args, vcu, G);
#ifdef MK_PROBE_A
    if (blockIdx.x == 0 && tid == 0) { const unsigned long long t8 = rt(); const unsigned long long dt = ts[MK_PROBE_HI] - ts[MK_PROBE_LO]; while (rt() < t8 + (unsigned long long)MK_PROBE_MULT * dt) __builtin_amdgcn_s_sleep(32); }
#endif
#undef IN
#undef BOTH
#undef GRID_BAR
}

extern "C" void kernel_launch(void* const* d_in, const int* in_sizes, int n_in, void* d_out, int out_size, void* d_ws, size_t ws_size, hipStream_t stream) {
    static int grid = 0;
    if (grid == 0) {
        if (n_in != 16 || out_size != M * DM || ws_size < WS_END) { fprintf(stderr, "kernel_launch: unexpected problem (n_in %d, out %d, ws %zu); nothing launched\n", n_in, out_size, ws_size); grid = -1; return; }
        int dev = 0, cus = 0, per_cu = 0;
        if (hipGetDevice(&dev) != hipSuccess || hipDeviceGetAttribute(&cus, hipDeviceAttributeMultiprocessorCount, dev) != hipSuccess) { grid = -1; return; }
        if (hipFuncSetAttribute((const void*)mk_fwd, hipFuncAttributeMaxDynamicSharedMemorySize, LDS_BYTES) != hipSuccess) { fprintf(stderr, "kernel_launch: hipFuncSetAttribute failed\n"); grid = -1; return; }
        if (hipOccupancyMaxActiveBlocksPerMultiprocessor(&per_cu, (const void*)mk_fwd, NWAVES * 64, LDS_BYTES) != hipSuccess || per_cu < 1) { fprintf(stderr, "kernel_launch: occupancy query says %d blocks per CU\n", per_cu); per_cu = 1; }
        (void)hipGetLastError();
        grid = cus;
    }
    if (grid < 0) return;
    if (hipMemsetAsync((char*)d_ws + WS_CTL, 0, CTL_ZERO_BYTES, stream) != hipSuccess) { fprintf(stderr, "kernel_launch: memset failed\n"); return; }
    Args a{};
    a.x = (const float*)d_in[0]; a.p = (const float*)d_in[1]; a.norm_in_g = (const float*)d_in[2]; a.w_in = (const float*)d_in[3]; a.conv_w = (const float*)d_in[4]; a.conv_b = (const float*)d_in[5];
    a.conv_ln_g = (const float*)d_in[6]; a.conv_ln_b = (const float*)d_in[7]; a.w_ba = (const float*)d_in[8]; a.w_bb = (const float*)d_in[9]; a.w_out = (const float*)d_in[10]; a.ple_g = (const float*)d_in[11];
    a.w_pg = (const float*)d_in[12]; a.w_pp = (const float*)d_in[13]; a.rel_bias = (const float*)d_in[14]; a.fin_g = (const float*)d_in[15];
    a.out = (float*)d_out; a.ws = (unsigned char*)d_ws;
    for (int li = 0; li < N_LAUNCHES; ++li) {
        if (N_LAUNCHES == 1) { a.ph_lo = 0; a.ph_hi = N_PHASES; } else { a.ph_lo = li; a.ph_hi = li + 1; }
        if (N_LAUNCHES == 1) {
            void* kargs[] = {&a};
            hipError_t e = hipLaunchCooperativeKernel((const void*)mk_fwd, dim3(grid), dim3(NWAVES * 64), kargs, LDS_BYTES, stream);
            if (e != hipSuccess) { (void)hipGetLastError(); fprintf(stderr, "kernel_launch: cooperative launch failed (%s); plain launch instead\n", hipGetErrorName(e)); hipLaunchKernelGGL(mk_fwd, dim3(grid), dim3(NWAVES * 64), LDS_BYTES, stream, a); }
        } else {
            hipLaunchKernelGGL(mk_fwd, dim3(grid), dim3(NWAVES * 64), LDS_BYTES, stream, a);
        }
        const hipError_t le = hipPeekAtLastError();
        if (le != hipSuccess) { fprintf(stderr, "kernel_launch: launch %d failed: %s\n", li, hipGetErrorName(le)); break; }
    }
}
```
